# Optimizing an MI355X kernel written in HIP

```python
import math
import jax, jax.numpy as jnp
from jax import lax
import numpy as np

D_MODEL = 1024
BATCH = 8
SEQ = 4096
DEPTH = 2

EPS = 1e-6
DA_HEADS = 8
DA_QK_DIM = 64
DA_V_DIM = 2 * DA_QK_DIM
DA_WIDTH = DA_HEADS * DA_V_DIM
Q_BLOCK = 128
ML_HEADS = 4
ML_QK_DIM = 128
ML_V_DIM = 256
ML_WIDTH = ML_HEADS * ML_V_DIM
ML_CHUNK = 128
CONV_WIDTH = 4
SG_GROUPS = 8
SG_CHUNK = 128
SG_WIDTH = 2 * D_MODEL
SG_GROUP_DIM = SG_WIDTH // SG_GROUPS

EVEN_SIZES = (
    DA_HEADS * 2 * DA_QK_DIM,
    DA_HEADS * 2 * DA_QK_DIM,
    DA_WIDTH,
    DA_WIDTH,
    2 * ML_HEADS * ML_QK_DIM,
    ML_WIDTH,
    ML_HEADS,
    ML_HEADS,
    ML_WIDTH,
    ML_WIDTH,
)
EVEN_IN = sum(EVEN_SIZES)
ODD_SIZES = (SG_WIDTH, SG_WIDTH, SG_WIDTH)
ODD_IN = sum(ODD_SIZES)

kernel_name = "hybrid_diffattn_mlstm_gmlp_block"


def _split(t, sizes):
    out, off = [], 0
    for n in sizes:
        out.append(t[..., off:off + n])
        off += n
    return out


def rmsnorm(x, g):
    xf = x.astype(jnp.float32)
    y = xf * lax.rsqrt(jnp.mean(xf * xf, axis=-1, keepdims=True) + EPS)
    return (y * g.astype(jnp.float32)).astype(x.dtype)


def causal_dwconv(x, w, b):
    S = x.shape[1]
    xp = jnp.pad(x, ((0, 0), (CONV_WIDTH - 1, 0), (0, 0)))
    return sum(w[j] * xp[:, j:j + S] for j in range(CONV_WIDTH)) + b


def diff_attention(q, k, v, lam):
    B, S = q.shape[:2]
    nb = S // Q_BLOCK
    qb = (q * DA_QK_DIM ** -0.5).reshape(B, nb, Q_BLOCK, DA_HEADS, 2, DA_QK_DIM)
    qb = qb.transpose(1, 0, 3, 4, 2, 5)
    kt = k.transpose(0, 2, 3, 1, 4)
    vt = v.transpose(0, 2, 1, 3)
    k_pos = jnp.arange(S)

    def block(args):
        qi, i = args
        s = jnp.einsum('bhcqd,bhckd->bhcqk', qi, kt).astype(jnp.float32)
        q_pos = i * Q_BLOCK + jnp.arange(Q_BLOCK)
        s = jnp.where(k_pos[None, :] <= q_pos[:, None], s, -jnp.inf)
        p = jax.nn.softmax(s, axis=-1)
        a = p[:, :, 0] - lam * p[:, :, 1]
        return jnp.einsum('bhqk,bhkv->bhqv', a.astype(vt.dtype), vt)

    o = lax.map(block, (qb, jnp.arange(nb)))
    return o.transpose(1, 0, 3, 2, 4).reshape(B, S, DA_HEADS, DA_V_DIM)


def mlstm_chunkwise(q, k, v, i_pre, f_pre):
    B, S, H, dk = q.shape
    dv = v.shape[-1]
    L = ML_CHUNK
    nc = S // L
    f32 = jnp.float32

    def chunks(t):
        t = t.astype(f32).reshape(B, nc, L, H, *t.shape[3:])
        return jnp.moveaxis(t, 3, 1)

    qc = chunks(q) * dk ** -0.5
    kc = chunks(k)
    vc = chunks(v)
    ic = chunks(i_pre)
    lf = jax.nn.log_sigmoid(chunks(f_pre))
    bcum = jnp.cumsum(lf, axis=-1)
    b_last = bcum[..., -1]
    g = b_last[..., None] - bcum + ic

    def step(carry, inp):
        C, n, m = carry
        bl, gs, ks, vs = inp
        m_new = jnp.maximum(bl + m, jnp.max(gs, axis=-1))
        decay = jnp.exp(bl + m - m_new)
        w = jnp.exp(gs - m_new[..., None])
        C_new = decay[..., None, None] * C + jnp.einsum('bhl,bhlk,bhlv->bhkv', w, ks, vs)
        n_new = decay[..., None] * n + jnp.einsum('bhl,bhlk->bhk', w, ks)
        return (C_new, n_new, m_new), (C, n, m)

    init = (jnp.zeros((B, H, dk, dv), f32), jnp.zeros((B, H, dk), f32), jnp.zeros((B, H), f32))
    xs = (jnp.moveaxis(b_last, 2, 0), jnp.moveaxis(g, 2, 0),
          jnp.moveaxis(kc, 2, 0), jnp.moveaxis(vc, 2, 0))
    _, (C_prev, n_prev, m_prev) = lax.scan(step, init, xs)
    C_prev = jnp.moveaxis(C_prev, 0, 2)
    n_prev = jnp.moveaxis(n_prev, 0, 2)
    m_prev = jnp.moveaxis(m_prev, 0, 2)

    causal = jnp.tril(jnp.ones((L, L), dtype=bool))
    log_d = bcum[..., :, None] - bcum[..., None, :] + ic[..., None, :]
    log_d = jnp.where(causal, log_d, -jnp.inf)
    log_inter = bcum + m_prev[..., None]
    m_t = jnp.maximum(log_inter, jnp.max(log_d, axis=-1))
    dmat = jnp.exp(log_d - m_t[..., None])
    inter_w = jnp.exp(log_inter - m_t)
    qk = jnp.einsum('bhctd,bhcsd->bhcts', qc, kc) * dmat
    num = (jnp.einsum('bhcts,bhcsv->bhctv', qk, vc)
           + inter_w[..., None] * jnp.einsum('bhctd,bhcdv->bhctv', qc, C_prev))
    den = jnp.sum(qk, axis=-1) + inter_w * jnp.einsum('bhctd,bhcd->bhct', qc, n_prev)
    h = num / jnp.maximum(jnp.abs(den), jnp.exp(-m_t))[..., None]
    h = jnp.moveaxis(h, 1, 3).reshape(B, S, H, dv)
    return h.astype(q.dtype)


def even_mixer(h, layer, w_in, b_igate, b_fgate, conv_w, conv_b,
               lambda_q1, lambda_k1, lambda_q2, lambda_k2, da_head_g, ml_head_g, w_out):
    B, S, _ = h.shape
    p = jnp.einsum('bsd,de->bse', h, w_in)
    da_q, da_k, da_v, da_z, ml_qk, ml_v, ml_i, ml_f, ml_o, ml_z = _split(p, EVEN_SIZES)

    f32 = jnp.float32
    lam_init = 0.8 - 0.6 * math.exp(-0.3 * layer)
    lam = (jnp.exp(jnp.dot(lambda_q1.astype(f32), lambda_k1.astype(f32)))
           - jnp.exp(jnp.dot(lambda_q2.astype(f32), lambda_k2.astype(f32))) + lam_init)
    o_a = diff_attention(da_q.reshape(B, S, DA_HEADS, 2, DA_QK_DIM),
                         da_k.reshape(B, S, DA_HEADS, 2, DA_QK_DIM),
                         da_v.reshape(B, S, DA_HEADS, DA_V_DIM), lam)
    o_a = rmsnorm(o_a, da_head_g) * (1.0 - lam_init)
    y_a = o_a.reshape(B, S, DA_WIDTH) * jax.nn.silu(da_z)

    qk = jax.nn.silu(causal_dwconv(ml_qk, conv_w, conv_b))
    ml_q, ml_k = _split(qk, (ML_HEADS * ML_QK_DIM, ML_HEADS * ML_QK_DIM))
    hm = mlstm_chunkwise(ml_q.reshape(B, S, ML_HEADS, ML_QK_DIM),
                         ml_k.reshape(B, S, ML_HEADS, ML_QK_DIM),
                         ml_v.reshape(B, S, ML_HEADS, ML_V_DIM),
                         ml_i + b_igate, ml_f + b_fgate)
    hm = hm * jax.nn.sigmoid(ml_o).reshape(B, S, ML_HEADS, ML_V_DIM)
    hm = rmsnorm(hm, ml_head_g)
    y_b = hm.reshape(B, S, ML_WIDTH) * jax.nn.silu(ml_z)

    y = jnp.concatenate([y_a, y_b], axis=-1)
    return jnp.einsum('bse,ed->bsd', y, w_out)


def odd_mixer(h, sg_norm_g, w_in, w_spatial, b_spatial, w_out):
    B, S, _ = h.shape
    nc = S // SG_CHUNK
    p = jnp.einsum('bsd,de->bse', h, w_in)
    u, v, z = _split(p, ODD_SIZES)
    u = jax.nn.gelu(u)
    v = rmsnorm(jax.nn.gelu(v), sg_norm_g)
    vg = v.reshape(B, nc, SG_CHUNK, SG_GROUPS, SG_GROUP_DIM)
    causal = jnp.tril(jnp.ones((SG_CHUNK, SG_CHUNK), dtype=w_spatial.dtype))
    wm = w_spatial * causal
    vs = jnp.einsum('gts,bcsgd->bctgd', wm, vg) + b_spatial.T[None, None, :, :, None]
    y = u * vs.reshape(B, S, SG_WIDTH) * jax.nn.silu(z)
    return jnp.einsum('bse,ed->bsd', y, w_out)


def setup_inputs(seed: int = 0) -> dict:
    key = jax.random.key(seed)
    ks = jax.random.split(key, 24)
    f32 = jnp.float32

    def nrm(k, shape, scale):
        return jax.random.normal(k, shape, f32) * scale

    def gain(k, n):
        return 1.0 + 0.05 * jax.random.normal(k, (n,), f32)

    return {
        "x": nrm(ks[0], (BATCH, SEQ, D_MODEL), 1.0),
        "l0_pre_g": gain(ks[1], D_MODEL),
        "l0_w_in": nrm(ks[2], (D_MODEL, EVEN_IN), D_MODEL ** -0.5),
        "l0_b_igate": nrm(ks[3], (ML_HEADS,), 0.1),
        "l0_b_fgate": 3.0 + nrm(ks[4], (ML_HEADS,), 0.5),
        "l0_conv_w": nrm(ks[5], (CONV_WIDTH, 2 * ML_HEADS * ML_QK_DIM), CONV_WIDTH ** -0.5),
        "l0_conv_b": nrm(ks[6], (2 * ML_HEADS * ML_QK_DIM,), 0.02),
        "l0_lambda_q1": nrm(ks[7], (DA_QK_DIM,), 0.1),
        "l0_lambda_k1": nrm(ks[8], (DA_QK_DIM,), 0.1),
        "l0_lambda_q2": nrm(ks[9], (DA_QK_DIM,), 0.1),
        "l0_lambda_k2": nrm(ks[10], (DA_QK_DIM,), 0.1),
        "l0_da_head_g": gain(ks[11], DA_V_DIM),
        "l0_ml_head_g": gain(ks[12], ML_V_DIM),
        "l0_w_out": nrm(ks[13], (DA_WIDTH + ML_WIDTH, D_MODEL), (DA_WIDTH + ML_WIDTH) ** -0.5),
        "l0_post_g": gain(ks[14], D_MODEL),
        "l1_pre_g": gain(ks[15], D_MODEL),
        "l1_w_in": nrm(ks[16], (D_MODEL, ODD_IN), D_MODEL ** -0.5),
        "l1_sg_norm_g": gain(ks[17], SG_WIDTH),
        "l1_w_spatial": nrm(ks[18], (SG_GROUPS, SG_CHUNK, SG_CHUNK), SG_CHUNK ** -0.5),
        "l1_b_spatial": 1.0 + nrm(ks[19], (SG_GROUPS, SG_CHUNK), 0.1),
        "l1_w_out": nrm(ks[20], (SG_WIDTH, D_MODEL), SG_WIDTH ** -0.5),
        "l1_post_g": gain(ks[21], D_MODEL),
    }


def reference(x, l0_pre_g, l0_w_in, l0_b_igate, l0_b_fgate, l0_conv_w, l0_conv_b,
              l0_lambda_q1, l0_lambda_k1, l0_lambda_q2, l0_lambda_k2, l0_da_head_g,
              l0_ml_head_g, l0_w_out, l0_post_g,
              l1_pre_g, l1_w_in, l1_sg_norm_g, l1_w_spatial, l1_b_spatial, l1_w_out, l1_post_g):
    layers = [
        (l0_pre_g, l0_post_g, (l0_w_in, l0_b_igate, l0_b_fgate, l0_conv_w, l0_conv_b,
                               l0_lambda_q1, l0_lambda_k1, l0_lambda_q2, l0_lambda_k2,
                               l0_da_head_g, l0_ml_head_g, l0_w_out)),
        (l1_pre_g, l1_post_g, (l1_sg_norm_g, l1_w_in, l1_w_spatial, l1_b_spatial, l1_w_out)),
    ]
    h = x
    for l in range(DEPTH):
        pre_g, post_g, params = layers[l]
        hn = rmsnorm(h, pre_g)
        if l % 2 == 0:
            y = even_mixer(hn, l, *params)
        else:
            y = odd_mixer(hn, *params)
        h = h + rmsnorm(y, post_g)
    return h
```

```cpp
#include <hip/hip_runtime.h>
#include <hip/hip_cooperative_groups.h>
#include <cstdio>
#include <cstdint>
namespace cg = cooperative_groups;
__device__ __forceinline__ int fresh_tid() { int t = (int)threadIdx.x; asm volatile("" : "+v"(t)); return t; }
namespace pg8 {
#define PG8_LAS __attribute__((address_space(3)))
typedef unsigned short bf16_t;
typedef short bf16x8 __attribute__((ext_vector_type(8)));
typedef float f32x4 __attribute__((ext_vector_type(4)));
typedef unsigned u32x4 __attribute__((ext_vector_type(4)));
constexpr int BM = 256, BK = 64, HALF = 128, HTB = HALF * BK * 2  , STAGE_BYTES = 8 * HTB, NXCD = 8, WGM = 8;

__host__ __device__ __forceinline__ int lds_byte(int r, int c) { const int st = (r >> 4) * 2 + (c >> 5), rr = r & 15, cc = c & 31, ob = rr * 64 + cc * 2; return st * 1024 + (ob ^ (((ob >> 9) & 1) << 5)); }
__host__ __device__ __forceinline__ void stage_rc(int b, int& R, int& C) { const int st = b / 1024, sb = b % 1024, swz = sb ^ (((sb >> 9) & 1) << 5); R = (st >> 1) * 16 + swz / 64; C = (st & 1) * 32 + (swz % 64) / 2; }
__host__ __device__ __forceinline__ int perm32(int rho) { const int n = rho >> 4, i = rho & 15; return 8 * (i >> 2) + 4 * n + (i & 3); }

struct Unit { int pm, pn; };
struct Gemm { const bf16_t* A; const bf16_t* Bt; int M, N, K, lda, ldb; };

struct StaticOrder {
    int nM, nN, nwg, G, c;
    __host__ __device__ void init(int M, int N, int G_, int c_) { nM = M / BM; nN = N / BM; nwg = nM * nN; G = G_; c = c_; }
    __host__ __device__ bool next(int i, Unit& u) const {
        const long L = (long)i * G + c; if (L >= nwg) return false;
        int wgid = (int)L; { const int q = nwg / NXCD, r = nwg % NXCD, xcd = wgid % NXCD, off = wgid / NXCD; wgid = (xcd < r ? xcd * (q + 1) : r * (q + 1) + (xcd - r) * q) + off; }
        const int nig = WGM * nN, gid = wgid / nig, fm = gid * WGM, gsz = (nM - fm) < WGM ? (nM - fm) : WGM;
        u.pm = fm + ((wgid % nig) % gsz); u.pn = (wgid % nig) / gsz; return true;
    }
    __device__ __forceinline__ void a_ready(const Unit&) const {}
    __device__ __forceinline__ void done(const Unit&) const {}
};

__device__ __forceinline__ unsigned cvt_pk_bf16(float lo, float hi) { unsigned r; asm volatile("v_cvt_pk_bf16_f32 %0, %1, %2" : "=v"(r) : "v"(lo), "v"(hi)); return r; }
typedef float f32x2 __attribute__((ext_vector_type(2)));
__device__ __forceinline__ f32x2 gelu_pk(f32x2 v) {
    const f32x2 av = __builtin_elementwise_abs(v), d = av * 0.2316418882f + 1.0f;
    f32x2 t; t.x = __builtin_amdgcn_rcpf(d.x); t.y = __builtin_amdgcn_rcpf(d.y);
    f32x2 q = t * 0.5307027145f + (-0.7265760135f); q = q * t + 0.7107068705f; q = q * t + (-0.142248368f); q = q * t + 0.127414796f; q = q * t;
    const f32x2 s = (v * v) * (-0.72134752044f);
    f32x2 e; e.x = __builtin_amdgcn_exp2f(s.x); e.y = __builtin_amdgcn_exp2f(s.y);
    const f32x2 m = v * (q * e), r = v - m;
    f32x2 o; o.x = v.x < 0.f ? m.x : r.x; o.y = v.y < 0.f ? m.y : r.y; return o;
}

template <int ACT  > struct EpiBf16 {
    static constexpr bool PERM = true, AFTER_DRAIN = false; static_assert(ACT == 0 || ACT == 1, "EpiBf16: ACT is 0 (none) or 1 (gelu_pk)");
    bf16_t* O; int ldc; const float* bias; int split_cols; size_t split_stride; float scale0;
    __device__ __forceinline__ void operator()(const f32x4 (&acc)[2][2][4][2], const Unit& u, int wr, int wc, int fr, int fq) const {
        const int row0 = u.pm * BM + wr * 64 + fr; int colt = u.pn * BM; bf16_t* base = O;
        float sc = 1.f; if (split_cols) { const int t = colt / split_cols; base += (size_t)t * split_stride; colt -= t * split_cols; if (t == 0) sc = scale0; }
        const int col0 = colt + wc * 32 + 8 * fq, bcol0 = u.pn * BM + wc * 32 + 8 * fq;
        f32x4 bv[2][2];
#pragma unroll
        for (int bj = 0; bj < 2; ++bj)
#pragma unroll
            for (int n = 0; n < 2; ++n) bv[bj][n] = bias ? *(const f32x4*)(bias + bcol0 + bj * HALF + 4 * n) : (f32x4){0.f, 0.f, 0.f, 0.f};
#pragma unroll
        for (int ai = 0; ai < 2; ++ai)
#pragma unroll
            for (int m = 0; m < 4; ++m) { bf16_t* rowp = base + (size_t)(row0 + ai * HALF + m * 16) * ldc + col0;
#pragma unroll
                for (int bj = 0; bj < 2; ++bj) { f32x4 v0 = acc[ai][bj][m][0] + bv[bj][0], v1 = acc[ai][bj][m][1] + bv[bj][1];
                    if (ACT == 1) { f32x2 a = gelu_pk((f32x2){v0[0], v0[1]}), b = gelu_pk((f32x2){v0[2], v0[3]}), c = gelu_pk((f32x2){v1[0], v1[1]}), d = gelu_pk((f32x2){v1[2], v1[3]});
                        v0 = (f32x4){a.x, a.y, b.x, b.y}; v1 = (f32x4){c.x, c.y, d.x, d.y}; }
                    v0 = v0 * sc; v1 = v1 * sc; u32x4 w; w.x = cvt_pk_bf16(v0[0], v0[1]); w.y = cvt_pk_bf16(v0[2], v0[3]); w.z = cvt_pk_bf16(v1[0], v1[1]); w.w = cvt_pk_bf16(v1[2], v1[3]);
                    *(u32x4*)(rowp + bj * HALF) = w; } }
    }
};
template <class Epi, class Sched, bool ALIGN_EPI = false, bool SP2 = false>
__device__ __forceinline__ void gemm_phase(PG8_LAS unsigned char* lds, const Gemm g, const Sched& S, const Epi& E) {
    const int tid = fresh_tid(), wid = __builtin_amdgcn_readfirstlane(tid >> 6), lane = tid & 63, wr = wid >> 2, wc = wid & 3, fr = lane & 15, fq = lane >> 4;
    const int K = g.K, nt = K / BK;
    unsigned voffA[2], voffB[2];
#pragma unroll
    for (int i = 0; i < 2; ++i) { int R, C; stage_rc(tid * 16 + i * 8192, R, C); const int Rb = Epi::PERM ? ((R & ~31) + perm32(R & 31)) : R;
        voffA[i] = (unsigned)(R * g.lda + C) * 2u; voffB[i] = (unsigned)(Rb * g.ldb + C) * 2u; }
    const size_t kstep = (size_t)(BK * 2);
    const size_t hstepA = (size_t)HALF * g.lda * 2, hstepB = (size_t)HALF * g.ldb * 2;
    const size_t tstepA = 2 * hstepA, tstepB = 2 * hstepB;
    const unsigned ldsw = (unsigned)wid * 1024u;
    const int aoff = lds_byte(wr * 64 + fr, fq * 8), boff = lds_byte(wc * 32 + fr, fq * 8);
#define PG8_SA(b, h) (((b) * 2 + (h)) * HTB)
#define PG8_SB(b, h) ((4 + (b) * 2 + (h)) * HTB)
#define PG8_STAGE(bufoff, gbase, voff) do { _Pragma("unroll") for (int _i = 0; _i < 2; ++_i) \
        __builtin_amdgcn_global_load_lds((const unsigned*)((const char*)(gbase) + (voff)[_i]), (PG8_LAS unsigned*)(lds + (bufoff) + ldsw + _i * 8192), 16, 0, 0); } while (0)
#define PG8_LDA(dst, b, h) do { _Pragma("unroll") for (int m = 0; m < 4; ++m) _Pragma("unroll") for (int k = 0; k < 2; ++k) dst[m][k] = *(const PG8_LAS bf16x8*)(lds + PG8_SA(b, h) + aoff + m * 2048 + k * 1024); } while (0)
#define PG8_LDB(dst, b, h) do { _Pragma("unroll") for (int n = 0; n < 2; ++n) _Pragma("unroll") for (int k = 0; k < 2; ++k) dst[n][k] = *(const PG8_LAS bf16x8*)(lds + PG8_SB(b, h) + boff + n * 2048 + k * 1024); } while (0)
#define PG8_MMA(ai, bj, At, Bt) do { __builtin_amdgcn_s_setprio(1); _Pragma("unroll") for (int m = 0; m < 4; ++m) _Pragma("unroll") for (int n = 0; n < 2; ++n) _Pragma("unroll") for (int k = 0; k < 2; ++k) \
        acc[ai][bj][m][n] = __builtin_amdgcn_mfma_f32_16x16x32_bf16(Bt[n][k], At[m][k], acc[ai][bj][m][n], 0, 0, 0); __builtin_amdgcn_s_setprio(0); } while (0)
#define PG8_WAIT_V(n) asm volatile("s_waitcnt vmcnt(" #n ")" ::: "memory")
#define PG8_WAIT_L(n) asm volatile("s_waitcnt lgkmcnt(" #n ")" ::: "memory")
#define PG8_BAR __builtin_amdgcn_s_barrier()
#define PG8_SCHED __builtin_amdgcn_sched_barrier(0)
    Unit cur, nxt; int ui = 0;
    if (!S.next(0, cur)) return;
    f32x4 acc[2][2][4][2];
#pragma unroll
    for (int a = 0; a < 2; ++a)
#pragma unroll
        for (int b = 0; b < 2; ++b)
#pragma unroll
            for (int m = 0; m < 4; ++m)
#pragma unroll
                for (int n = 0; n < 2; ++n) acc[a][b][m][n] = (f32x4){0.f, 0.f, 0.f, 0.f};
    bf16x8 At[4][2], B0[2][2], B1[2][2];
    const char* cA = (const char*)g.A + (size_t)cur.pm * tstepA; const char* cB = (const char*)g.Bt + (size_t)cur.pn * tstepB;
    S.a_ready(cur);
    if constexpr (SP2) {
        PG8_STAGE(PG8_SB(0, 0), cB, voffB); PG8_STAGE(PG8_SB(0, 1), cB + hstepB, voffB); PG8_STAGE(PG8_SA(0, 0), cA, voffA); PG8_STAGE(PG8_SA(0, 1), cA + hstepA, voffA);
        if (wr == 1) PG8_BAR;
        PG8_WAIT_V(2); PG8_BAR;
        PG8_STAGE(PG8_SB(1, 0), cB + kstep, voffB); PG8_STAGE(PG8_SA(1, 0), cA + kstep, voffA); PG8_STAGE(PG8_SB(1, 1), cB + hstepB + kstep, voffB);
        PG8_WAIT_V(6); PG8_BAR;
    } else {
        PG8_STAGE(PG8_SB(0, 0), cB, voffB); PG8_STAGE(PG8_SA(0, 0), cA, voffA); PG8_STAGE(PG8_SB(0, 1), cB + hstepB, voffB); PG8_STAGE(PG8_SA(0, 1), cA + hstepA, voffA);
        if (wr == 1) PG8_BAR;
        PG8_WAIT_V(4); PG8_BAR;
        PG8_STAGE(PG8_SB(1, 0), cB + kstep, voffB); PG8_STAGE(PG8_SA(1, 0), cA + kstep, voffA); PG8_STAGE(PG8_SB(1, 1), cB + hstepB + kstep, voffB);
        PG8_WAIT_V(6); PG8_BAR;
    }
    for (;;) {
        const bool has_next = S.next(ui + 1, nxt);
        const char* nA = has_next ? (const char*)g.A + (size_t)nxt.pm * tstepA : cA; const char* nB = has_next ? (const char*)g.Bt + (size_t)nxt.pn * tstepB : cB;
        for (int t = 0; t < nt; t += 2) {
            const bool last = (t == nt - 2);
            const char* a1 = cA + (size_t)(t + 1) * kstep;
            const char* a2 = last ? nA : cA + (size_t)(t + 2) * kstep; const char* b2 = last ? nB : cB + (size_t)(t + 2) * kstep;
            const char* a3 = a2 + kstep; const char* b3 = b2 + kstep;
            if (last && has_next) S.a_ready(nxt);
            if constexpr (SP2) {
            PG8_LDB(B0, 0, 0); PG8_LDB(B1, 0, 1); PG8_SCHED; PG8_LDA(At, 0, 0); PG8_STAGE(PG8_SA(1, 1), a1 + hstepA, voffA);
            PG8_WAIT_V(8); PG8_WAIT_L(0); PG8_BAR; PG8_MMA(0, 0, At, B0); PG8_MMA(0, 1, At, B1); PG8_BAR; PG8_SCHED;
            PG8_LDA(At, 0, 1); PG8_STAGE(PG8_SB(0, 0), b2, voffB); PG8_STAGE(PG8_SB(0, 1), b2 + hstepB, voffB); PG8_STAGE(PG8_SA(0, 0), a2, voffA);
            PG8_WAIT_V(8); PG8_WAIT_L(0); PG8_BAR; PG8_MMA(1, 0, At, B0); PG8_MMA(1, 1, At, B1); PG8_BAR; PG8_SCHED;
            PG8_LDB(B0, 1, 0); PG8_LDB(B1, 1, 1); PG8_SCHED; PG8_LDA(At, 1, 0); PG8_STAGE(PG8_SA(0, 1), a2 + hstepA, voffA);
            PG8_WAIT_V(8); PG8_WAIT_L(0); PG8_BAR; PG8_MMA(0, 0, At, B0); PG8_MMA(0, 1, At, B1); PG8_BAR; PG8_SCHED;
            PG8_LDA(At, 1, 1); PG8_STAGE(PG8_SB(1, 0), b3, voffB); PG8_STAGE(PG8_SB(1, 1), b3 + hstepB, voffB); PG8_STAGE(PG8_SA(1, 0), a3, voffA);
            PG8_WAIT_V(8); PG8_WAIT_L(0); PG8_BAR; PG8_MMA(1, 0, At, B0); PG8_MMA(1, 1, At, B1); PG8_BAR; PG8_SCHED;
            } else {
            PG8_LDB(B0, 0, 0); PG8_SCHED; PG8_LDA(At, 0, 0); PG8_STAGE(PG8_SA(1, 1), a1 + hstepA, voffA);
            PG8_WAIT_L(8); PG8_BAR; PG8_WAIT_L(0); PG8_MMA(0, 0, At, B0); PG8_BAR; PG8_SCHED;
            PG8_LDB(B1, 0, 1); PG8_STAGE(PG8_SB(0, 0), b2, voffB);
            PG8_BAR; PG8_WAIT_L(0); PG8_MMA(0, 1, At, B1); PG8_BAR;
            PG8_LDA(At, 0, 1); PG8_STAGE(PG8_SA(0, 0), a2, voffA);
            PG8_BAR; PG8_WAIT_L(0); PG8_MMA(1, 0, At, B0); PG8_BAR; PG8_SCHED;
            PG8_STAGE(PG8_SB(0, 1), b2 + hstepB, voffB);
            PG8_WAIT_V(6); PG8_BAR; PG8_MMA(1, 1, At, B1); PG8_BAR;
            PG8_LDB(B0, 1, 0); PG8_SCHED; PG8_LDA(At, 1, 0); PG8_STAGE(PG8_SA(0, 1), a2 + hstepA, voffA);
            PG8_WAIT_L(8); PG8_BAR; PG8_WAIT_L(0); PG8_MMA(0, 0, At, B0); PG8_BAR; PG8_SCHED;
            PG8_LDB(B1, 1, 1); PG8_STAGE(PG8_SB(1, 0), b3, voffB);
            PG8_BAR; PG8_WAIT_L(0); PG8_MMA(0, 1, At, B1); PG8_BAR;
            PG8_LDA(At, 1, 1); PG8_STAGE(PG8_SA(1, 0), a3, voffA);
            PG8_BAR; PG8_WAIT_L(0); PG8_MMA(1, 0, At, B0); PG8_BAR; PG8_SCHED;
            PG8_STAGE(PG8_SB(1, 1), b3 + hstepB, voffB);
            PG8_WAIT_V(6); PG8_BAR; PG8_MMA(1, 1, At, B1); PG8_BAR;
            }
        }
        if constexpr (ALIGN_EPI) { if (wr == 0) PG8_BAR; }
        if constexpr (!Epi::AFTER_DRAIN) { E(acc, cur, wr, wc, fr, fq); S.done(cur); }
        if (!has_next) break;
#pragma unroll
        for (int a = 0; a < 2; ++a)
#pragma unroll
            for (int b = 0; b < 2; ++b)
#pragma unroll
                for (int m = 0; m < 4; ++m)
#pragma unroll
                    for (int n = 0; n < 2; ++n) acc[a][b][m][n] = (f32x4){0.f, 0.f, 0.f, 0.f};
        cur = nxt; cA = nA; cB = nB; ++ui;
        if constexpr (ALIGN_EPI) { if (wr == 1) PG8_BAR; }
    }
    PG8_WAIT_V(0);
    if constexpr (!ALIGN_EPI) { if (wr == 0) PG8_BAR; }
    PG8_BAR;
    if constexpr (Epi::AFTER_DRAIN) { E.fused(acc, cur, wr, wc, fr, fq, lds, wid, lane); S.done(cur); }
#undef PG8_SA
#undef PG8_SB
#undef PG8_STAGE
#undef PG8_LDA
#undef PG8_LDB
#undef PG8_MMA
#undef PG8_WAIT_V
#undef PG8_WAIT_L
#undef PG8_BAR
#undef PG8_SCHED
}
}
namespace pg8 {
__device__ __forceinline__ float act_gelu_tanh(float x) {
    const float u = x * (1.0f + 0.044715f * x * x) * (-2.0f * 0.7978845608028654f * 1.4426950408889634f);
    return x * __builtin_amdgcn_rcpf(1.0f + __builtin_amdgcn_exp2f(u));
}
__device__ __forceinline__ float act_silu(float x) { return x * __builtin_amdgcn_rcpf(1.0f + __builtin_amdgcn_exp2f(x * -1.4426950408889634f)); }
template <int ACT> __device__ __forceinline__ float act_apply(float x) { if (ACT == 1) return act_gelu_tanh(x); if (ACT == 2) return act_silu(x); return x; }

constexpr size_t UNIT = (size_t)64 << 20;

struct Epi1 {
    static constexpr bool PERM = true, AFTER_DRAIN = false;
    unsigned char* ws; unsigned char* outb; float qscale;
    __device__ __forceinline__ void operator()(const f32x4 (&acc)[2][2][4][2], const Unit& u, int wr, int wc, int fr, int fq) const {
        const int seg = u.pn >> 2; int colt = (u.pn & 3) * BM; int ldc = 1024; float sc = 1.f;
        unsigned char* bb = ws + (size_t)seg * UNIT;
        if (seg == 0) sc = qscale;
        if (seg == 3) { bb = ws + 3 * UNIT; ldc = 2048; }
        if (seg == 4) { bb = outb; }
        if (seg == 5) { bb = outb + UNIT; }
        if (seg == 6) { bb = ws + 3 * UNIT; ldc = 2048; colt += 1024; }
        bf16_t* base = (bf16_t*)bb;
        const int row0 = u.pm * BM + wr * 64 + fr, col0 = colt + wc * 32 + 8 * fq;
#pragma unroll
        for (int ai = 0; ai < 2; ++ai)
#pragma unroll
            for (int m = 0; m < 4; ++m) { bf16_t* rowp = base + (size_t)(row0 + ai * HALF + m * 16) * ldc + col0;
#pragma unroll
                for (int bj = 0; bj < 2; ++bj) { const f32x4 v0 = acc[ai][bj][m][0] * sc, v1 = acc[ai][bj][m][1] * sc;
                    u32x4 w; w.x = cvt_pk_bf16(v0[0], v0[1]); w.y = cvt_pk_bf16(v0[2], v0[3]); w.z = cvt_pk_bf16(v1[0], v1[1]); w.w = cvt_pk_bf16(v1[2], v1[3]);
                    *(u32x4*)(rowp + bj * HALF) = w; } }
    }
};
struct EpiUZ {
    static constexpr bool PERM = true, AFTER_DRAIN = false;
    bf16_t* U; bf16_t* SZ;
    __device__ __forceinline__ void operator()(const f32x4 (&acc)[2][2][4][2], const Unit& u, int wr, int wc, int fr, int fq) const {
        const bool isz = u.pn >= 8; bf16_t* base = isz ? SZ : U; const int colt = (u.pn & 7) * BM;
        const int row0 = u.pm * BM + wr * 64 + fr, col0 = colt + wc * 32 + 8 * fq;
#pragma unroll
        for (int ai = 0; ai < 2; ++ai)
#pragma unroll
            for (int m = 0; m < 4; ++m) { bf16_t* rowp = base + (size_t)(row0 + ai * HALF + m * 16) * 2048 + col0;
#pragma unroll
                for (int bj = 0; bj < 2; ++bj) { f32x4 v0 = acc[ai][bj][m][0], v1 = acc[ai][bj][m][1];
                    if (isz) {
#pragma unroll
                        for (int e = 0; e < 4; ++e) { v0[e] = act_silu(v0[e]); v1[e] = act_silu(v1[e]); }
                    } else {
#pragma unroll
                        for (int e = 0; e < 4; ++e) { v0[e] = act_gelu_tanh(v0[e]); v1[e] = act_gelu_tanh(v1[e]); }
                    }
                    u32x4 w; w.x = cvt_pk_bf16(v0[0], v0[1]); w.y = cvt_pk_bf16(v0[2], v0[3]); w.z = cvt_pk_bf16(v1[0], v1[1]); w.w = cvt_pk_bf16(v1[2], v1[3]);
                    *(u32x4*)(rowp + bj * HALF) = w; } }
    }
};
template <int ACT, bool CSQ> struct EpiT {
    static constexpr bool PERM = true, AFTER_DRAIN = false;
    bf16_t* O; int ldc; float* csq; int ntok;
    __device__ __forceinline__ void operator()(const f32x4 (&acc)[2][2][4][2], const Unit& u, int wr, int wc, int fr, int fq) const {
        const int row0 = u.pm * BM + wr * 64 + fr, col0 = u.pn * BM + wc * 32 + 8 * fq;
        f32x4 cs[2][2];
#pragma unroll
        for (int bj = 0; bj < 2; ++bj) { cs[bj][0] = (f32x4){0.f, 0.f, 0.f, 0.f}; cs[bj][1] = (f32x4){0.f, 0.f, 0.f, 0.f}; }
#pragma unroll
        for (int ai = 0; ai < 2; ++ai)
#pragma unroll
            for (int m = 0; m < 4; ++m) { bf16_t* rowp = O + (size_t)(row0 + ai * HALF + m * 16) * ldc + col0;
#pragma unroll
                for (int bj = 0; bj < 2; ++bj) { f32x4 v0 = acc[ai][bj][m][0], v1 = acc[ai][bj][m][1];
#pragma unroll
                    for (int e = 0; e < 4; ++e) { v0[e] = act_apply<ACT>(v0[e]); v1[e] = act_apply<ACT>(v1[e]); }
                    if (CSQ) { cs[bj][0] += v0 * v0; cs[bj][1] += v1 * v1; }
                    u32x4 w; w.x = cvt_pk_bf16(v0[0], v0[1]); w.y = cvt_pk_bf16(v0[2], v0[3]); w.z = cvt_pk_bf16(v1[0], v1[1]); w.w = cvt_pk_bf16(v1[2], v1[3]);
                    *(u32x4*)(rowp + bj * HALF) = w; } }
        if (CSQ) {
#pragma unroll
            for (int bj = 0; bj < 2; ++bj)
#pragma unroll
                for (int n = 0; n < 2; ++n) { f32x4 s = cs[bj][n];
#pragma unroll
                    for (int e = 0; e < 4; ++e) { float t = s[e]; t += __shfl_xor(t, 1); t += __shfl_xor(t, 2); t += __shfl_xor(t, 4); t += __shfl_xor(t, 8); s[e] = t; }
                    if (fr == 0) *(f32x4*)(csq + (size_t)(2 * u.pm + wr) * ntok + col0 + bj * HALF + 4 * n) = s; }
        }
    }
};
struct EpiY {
    static constexpr bool PERM = true, AFTER_DRAIN = false;
    bf16_t* O; float* rsq; int nrow;
    __device__ __forceinline__ void operator()(const f32x4 (&acc)[2][2][4][2], const Unit& u, int wr, int wc, int fr, int fq) const {
        const int row0 = u.pm * BM + wr * 64 + fr, col0 = u.pn * BM + wc * 32 + 8 * fq;
#pragma unroll
        for (int ai = 0; ai < 2; ++ai)
#pragma unroll
            for (int m = 0; m < 4; ++m) { const int row = row0 + ai * HALF + m * 16; bf16_t* rowp = O + (size_t)row * 1024 + col0; float s = 0.f;
#pragma unroll
                for (int bj = 0; bj < 2; ++bj) { const f32x4 v0 = acc[ai][bj][m][0], v1 = acc[ai][bj][m][1];
                    s += (v0[0] * v0[0] + v0[1] * v0[1]) + (v0[2] * v0[2] + v0[3] * v0[3]) + (v1[0] * v1[0] + v1[1] * v1[1]) + (v1[2] * v1[2] + v1[3] * v1[3]);
                    u32x4 w; w.x = cvt_pk_bf16(v0[0], v0[1]); w.y = cvt_pk_bf16(v0[2], v0[3]); w.z = cvt_pk_bf16(v1[0], v1[1]); w.w = cvt_pk_bf16(v1[2], v1[3]);
                    *(u32x4*)(rowp + bj * HALF) = w; }
                s += __shfl_xor(s, 16); s += __shfl_xor(s, 32);
                if (fq == 0) rsq[(size_t)(4 * u.pn + wc) * nrow + row] = s; }
    }
};
}
#include <hip/hip_bf16.h>
#include <cmath>
namespace attn_body {
using bf16=__hip_bfloat16;
using bf16x8=__attribute__((ext_vector_type(8)))short;
using s16x4=__attribute__((ext_vector_type(4)))short;
using f32x16=__attribute__((ext_vector_type(16)))float;
using u32x4=__attribute__((ext_vector_type(4)))unsigned;
constexpr int BATCH=8,NHEAD=16,SEQ=4096,D=64,DM=1024;
constexpr int NW=8,QBLK=32,QB=QBLK*NW,KVBLK=64,NQB=SEQ/QB;
constexpr int ATTN_PITCH=DM, ATTN_UNIT_ROWS=QB;
__device__ __forceinline__ int crow(int r,int hi){return (r&3)+8*(r>>2)+4*hi;}
#define SBAR() __builtin_amdgcn_sched_barrier(0)
__device__ __forceinline__ void cmask(f32x16&p0,f32x16&p1,int jb,int qrel,int hi){
  const float NEG=-INFINITY; int kb=64*jb+4*hi;
  #pragma unroll
  for(int r=0;r<16;++r){int kv=kb+(r&3)+8*(r>>2); if(kv>qrel)p0[r]=NEG; if(kv+32>qrel)p1[r]=NEG;}
}

constexpr int NSLOT=3, SLOTB=8192;
constexpr int LDS_K=0, LDS_V=NSLOT*SLOTB, LDS_WS=2*NSLOT*SLOTB, LDS_OST=LDS_WS+NW*64*4, LDS_BYTES=LDS_OST+NW*4096;
constexpr float C2=0.125f*1.4426950408889634f;
__device__ __forceinline__ void glds16(const void*gsrc,unsigned lds_dst){unsigned keep;
  asm volatile("s_mov_b32 %0, m0\n\ts_mov_b32 m0, %2\n\ts_nop 0\n\tglobal_load_lds_dwordx4 %1, off\n\ts_mov_b32 m0, %0":"=&s"(keep):"v"(gsrc),"s"(lds_dst):"memory");}
__device__ __forceinline__ float max3f(float a,float b,float c){float r;asm("v_max3_f32 %0, %1, %2, %3":"=v"(r):"v"(a),"v"(b),"v"(c));return r;}
__device__ __forceinline__ float max2f(float a,float b){float r;asm("v_max_f32_e32 %0, %1, %2":"=v"(r):"v"(a),"v"(b));return r;}
__device__ __forceinline__ float fadd_s(float a,float b){float r;asm("v_add_f32_e32 %0, %1, %2":"=v"(r):"v"(a),"v"(b));return r;}
__device__ __forceinline__ float fsub_s(float a,float b){float r;asm("v_sub_f32_e32 %0, %1, %2":"=v"(r):"v"(a),"v"(b));return r;}
typedef float f32x2_t __attribute__((ext_vector_type(2))); typedef __bf16 bf16x2_t __attribute__((ext_vector_type(2)));
__device__ __forceinline__ unsigned cvtpk_s(float lo,float hi){f32x2_t v={lo,hi};bf16x2_t b=__builtin_convertvector(v,bf16x2_t);return __builtin_bit_cast(unsigned,b);}
#define WAIT_BAR(N) asm volatile("s_waitcnt vmcnt(" #N ") lgkmcnt(0)\n\ts_barrier":::"memory")

__device__ __forceinline__ void qkt(f32x16&p0,f32x16&p1,const char*Kslot,const bf16x8*qr,const f32x16&negm,int r32,int hi){
  const char*kb=Kslot+hi*1024+r32*16;
  #pragma unroll
  for(int d0=0;d0<4;++d0){
    const bf16x8 b0=*reinterpret_cast<const bf16x8*>(kb+d0*2048);
    const bf16x8 b1=*reinterpret_cast<const bf16x8*>(kb+d0*2048+512);
    if(d0==0){p0=__builtin_amdgcn_mfma_f32_32x32x16_bf16(b0,qr[0],negm,0,0,0);p1=__builtin_amdgcn_mfma_f32_32x32x16_bf16(b1,qr[0],negm,0,0,0);}
    else{p0=__builtin_amdgcn_mfma_f32_32x32x16_bf16(b0,qr[d0],p0,0,0,0);p1=__builtin_amdgcn_mfma_f32_32x32x16_bf16(b1,qr[d0],p1,0,0,0);}}
}
typedef __attribute__((address_space(3))) const char* lds_cptr;
typedef short v4i16_t __attribute__((ext_vector_type(4)));
__device__ __forceinline__ void kload8(bf16x8*kf,lds_cptr kp){
  kf[0]=*(const __attribute__((address_space(3))) bf16x8*)(kp);      kf[1]=*(const __attribute__((address_space(3))) bf16x8*)(kp+512);
  kf[2]=*(const __attribute__((address_space(3))) bf16x8*)(kp+2048); kf[3]=*(const __attribute__((address_space(3))) bf16x8*)(kp+2560);
  kf[4]=*(const __attribute__((address_space(3))) bf16x8*)(kp+4096); kf[5]=*(const __attribute__((address_space(3))) bf16x8*)(kp+4608);
  kf[6]=*(const __attribute__((address_space(3))) bf16x8*)(kp+6144); kf[7]=*(const __attribute__((address_space(3))) bf16x8*)(kp+6656);
}
__device__ __forceinline__ void kload2(bf16x8*kf,lds_cptr kp,int j){ kf[2*j]=*(const __attribute__((address_space(3))) bf16x8*)(kp+j*2048); kf[2*j+1]=*(const __attribute__((address_space(3))) bf16x8*)(kp+j*2048+512); }
__device__ __forceinline__ s16x4 vtr(lds_cptr p){ return __builtin_bit_cast(s16x4,__builtin_amdgcn_ds_read_tr16_b64_v4i16((__attribute__((address_space(3))) v4i16_t*)p)); }
__device__ __forceinline__ float rowmax(const f32x16&p0,const f32x16&p1){
  float a=max3f(p0[0],p0[1],p1[0]),b=max3f(p0[2],p0[3],p1[1]);a=max3f(a,p1[2],p1[3]);
  #pragma unroll
  for(int r=4;r<16;r+=4){a=max3f(a,p0[r],p0[r+1]);b=max3f(b,p0[r+2],p0[r+3]);a=max3f(a,p1[r],p1[r+1]);b=max3f(b,p1[r+2],p1[r+3]);}
  const float m=max2f(a,b);
  auto rr=__builtin_amdgcn_permlane32_swap(__float_as_uint(m),__float_as_uint(m),false,false);
  return max2f(__uint_as_float(rr[0]),__uint_as_float(rr[1]));
}
__device__ __forceinline__ void pv(f32x16*o,int vb,bf16x8 pa0,bf16x8 pa1,bf16x8 pa2,bf16x8 pa3){
  #pragma unroll
  for(int d0=0;d0<2;++d0){s16x4 lo[4],hi[4];
    #pragma unroll
    for(int ks=0;ks<4;++ks){
      asm volatile("ds_read_b64_tr_b16 %0,%1 offset:%c2":"=&v"(lo[ks]):"v"(vb),"i"(d0*4096+ks*1024):"memory");
      asm volatile("ds_read_b64_tr_b16 %0,%1 offset:%c2":"=&v"(hi[ks]):"v"(vb),"i"(d0*4096+ks*1024+512):"memory");}
    asm volatile("s_waitcnt lgkmcnt(0)":::"memory");SBAR();
    #define PK(k) (bf16x8){lo[k][0],lo[k][1],lo[k][2],lo[k][3],hi[k][0],hi[k][1],hi[k][2],hi[k][3]}
    o[d0]=__builtin_amdgcn_mfma_f32_32x32x16_bf16(pa0,PK(0),o[d0],0,0,0);
    o[d0]=__builtin_amdgcn_mfma_f32_32x32x16_bf16(pa1,PK(1),o[d0],0,0,0);
    o[d0]=__builtin_amdgcn_mfma_f32_32x32x16_bf16(pa2,PK(2),o[d0],0,0,0);
    o[d0]=__builtin_amdgcn_mfma_f32_32x32x16_bf16(pa3,PK(3),o[d0],0,0,0);
    #undef PK
  }
}

#ifndef ATTN_STORE16
#define ATTN_STORE16(p,v) (*(u32x4*)(p)=(v))
#endif
template<int THRL> __device__ __forceinline__ void attn_unit(int b,int qc,int kc,int vc,int oc,int qb,const bf16*Q,const bf16*__restrict__ K,const bf16*__restrict__ V,bf16*O,char*shm){
  const int tid=fresh_tid(),lane=tid&63,r32=lane&31,hi=lane>>5; const int wid=__builtin_amdgcn_readfirstlane(tid>>6);
  const long rowbase=(long)b*SEQ; const int q0=qb*QB;
  const bf16*Qw=Q+(rowbase+q0+wid*QBLK)*DM+qc;
  const bf16*Kh=K+rowbase*DM+kc,*Vh=V+rowbase*DM+vc;
  const unsigned lds0=(unsigned)(uintptr_t)shm;
  float*wsf=(float*)(shm+LDS_WS)+wid*64;
  const bf16*ksrc=Kh+(long)lane*DM+wid*8;
  const bf16*vsrc=Vh+(long)(16*(wid&3)+(lane>>2))*DM+(wid>>2)*32+(lane&3)*8;
  const unsigned kdst=lds0+LDS_K+wid*1024, vdst=lds0+LDS_V+wid*1024;
  #define DMA_K(t,slot) glds16(ksrc+(long)(t)*KVBLK*DM,(unsigned)__builtin_amdgcn_readfirstlane(kdst+(slot)))
  #define DMA_V(t,slot) glds16(vsrc+(long)(t)*KVBLK*DM,(unsigned)__builtin_amdgcn_readfirstlane(vdst+(slot)))
  const int vb0=(int)(lds0+LDS_V)+((lane>>4)&1)*32+(lane&3)*8+(4*hi+((lane&15)>>2))*64;
  const char*Kbase=shm+LDS_K; bf16x8 kf[8];
  const lds_cptr shm3=(lds_cptr)shm; const lds_cptr kp0=shm3+LDS_K+hi*1024+r32*16; const lds_cptr vp0=shm3+LDS_V+((lane>>4)&1)*32+(lane&3)*8+(4*hi+((lane&15)>>2))*64;
  const int NT=(q0+QB)/KVBLK;
  DMA_K(0,0);DMA_V(0,0);DMA_K(1,SLOTB);
  bf16x8 qr[4];
  #pragma unroll
  for(int d0=0;d0<4;++d0)qr[d0]=*reinterpret_cast<const bf16x8*>(&Qw[(long)r32*DM+d0*16+hi*8]);
  float mhat=0.f,l_reg=0.f;f32x16 o[2];o[0]=f32x16{};o[1]=f32x16{};const f32x16 zero16=f32x16{};
  const int qrel=wid*QBLK+r32;
  #define CMASK(P0,P1,t) do{int jb_=(t)-(NT-4); if(jb_>=0)cmask(P0,P1,jb_,qrel,hi);}while(0)
  bool resc=false;
  #define START(P0,P1) do{ const float rm=rowmax(P0,P1); resc=false; \
    { const float dl=rm; mhat=fadd_s(mhat,dl); \
      _Pragma("unroll") for(int r=0;r<16;++r){P0[r]=fsub_s(P0[r],dl);P1[r]=fsub_s(P1[r],dl);} \
      } \
    _Pragma("unroll") for(int r=0;r<16;++r)P0[r]=__builtin_amdgcn_exp2f(P0[r]); }while(0)
  #define RESC() do{ if(resc){ asm volatile("s_waitcnt lgkmcnt(0)":::"memory"); \
      _Pragma("unroll") for(int d_=0;d_<2;++d_) _Pragma("unroll") for(int r=0;r<16;++r)o[d_][r]*=wsf[crow(r,hi)]; } }while(0)
  f32x16 pA0,pA1,pB0,pB1;
  int sl_prev=0,sl_cur=0,sl_next=SLOTB;
  #define ROT() do{sl_prev=sl_cur;sl_cur=sl_next;sl_next=(sl_next==(NSLOT-1)*SLOTB)?0:sl_next+SLOTB;}while(0)
  DMA_K(2,2*SLOTB);
  WAIT_BAR(3);
  qkt(pA0,pA1,Kbase,qr,zero16,r32,hi);asm volatile("s_nop 15\n\ts_nop 7":"+v"(pA0),"+v"(pA1));CMASK(pA0,pA1,0);
  START(pA0,pA1);
  _Pragma("unroll") for(int r=0;r<16;++r)pA1[r]=__builtin_amdgcn_exp2f(pA1[r]);
  WAIT_BAR(0);
  DMA_K(3,0);DMA_V(1,SLOTB);
  ROT();
  kload8(kf,kp0+sl_cur);
  WAIT_BAR(2);
  s16x4 vlo[8],vhi[8]; u32x4 pw0,pw1,pw2,pw3;
  #define PKW(P,B) cvtpk_s(P[B],P[B+1])
  #define PAF(k) __builtin_bit_cast(bf16x8,pw##k)
  #define VFR(i) (bf16x8){vlo[i][0],vlo[i][1],vlo[i][2],vlo[i][3],vhi[i][0],vhi[i][1],vhi[i][2],vhi[i][3]}
  #define PIN(x) asm volatile("":"+v"(x))
  #define MX3(a,b,c) __builtin_fmaxf(__builtin_fmaxf((a),(b)),(c))
  #define GAPA(MF,A0,A1,A2,A3,W0,W1,PW) do{ MF; sacc+=A0; sacc+=A1; sacc+=A2; sacc+=A3; PIN(sacc); W0; W1; PIN(PW); SBAR(); }while(0)
  #define EX(v) __builtin_amdgcn_exp2f(v)
  #define GAPB(MF,X,B) do{ MF; X[B]=EX(X[B]); X[B+1]=EX(X[B+1]); X[B+2]=EX(X[B+2]); X[B+3]=EX(X[B+3]); PIN(X); SBAR(); }while(0)
  #define VRD(i) do{ vlo[i]=vtr(vp_+(((i)>>2)*4096+((i)&3)*1024)); vhi[i]=vtr(vp_+(((i)>>2)*4096+((i)&3)*1024+512)); }while(0)
  #define KRD(G,j) do{ if(G){ kload2(kf,kp0+sl_next,j); SBAR(); } }while(0)
  #define STEP(C0,C1,P0,P1,t,GK,GV,GL) do{ SBAR(); \
    const lds_cptr vp_=vp0+sl_prev; \
    VRD(0); SBAR(); float sacc=(P0[0]+P0[1]); \
    GAPA(C0=__builtin_amdgcn_mfma_f32_32x32x16_bf16(kf[0],qr[0],zero16,0,0,0), P0[2],P0[3],P0[4],P0[5],     pw0[0]=PKW(P0,0), pw0[1]=PKW(P0,2), pw0); \
    VRD(4); SBAR(); GAPA(C1=__builtin_amdgcn_mfma_f32_32x32x16_bf16(kf[1],qr[0],zero16,0,0,0), P0[6],P0[7],P0[8],P0[9],     pw0[2]=PKW(P0,4), pw0[3]=PKW(P0,6), pw0); \
    VRD(1); SBAR(); GAPA(C0=__builtin_amdgcn_mfma_f32_32x32x16_bf16(kf[2],qr[1],C0,0,0,0),   P0[10],P0[11],P0[12],P0[13], pw1[0]=PKW(P0,8), pw1[1]=PKW(P0,10), pw1); \
    VRD(5); SBAR(); GAPA(C1=__builtin_amdgcn_mfma_f32_32x32x16_bf16(kf[3],qr[1],C1,0,0,0),   P0[14],P0[15],P1[0],P1[1],   pw1[2]=PKW(P0,12),pw1[3]=PKW(P0,14), pw1); \
    VRD(2); SBAR(); GAPA(C0=__builtin_amdgcn_mfma_f32_32x32x16_bf16(kf[4],qr[2],C0,0,0,0),   P1[2],P1[3],P1[4],P1[5],     pw2[0]=PKW(P1,0), pw2[1]=PKW(P1,2), pw2); \
    VRD(6); SBAR(); GAPA(C1=__builtin_amdgcn_mfma_f32_32x32x16_bf16(kf[5],qr[2],C1,0,0,0),   P1[6],P1[7],P1[8],P1[9],     pw2[2]=PKW(P1,4), pw2[3]=PKW(P1,6), pw2); \
    VRD(3); SBAR(); GAPA(C0=__builtin_amdgcn_mfma_f32_32x32x16_bf16(kf[6],qr[3],C0,0,0,0),   P1[10],P1[11],P1[12],P1[13], pw3[0]=PKW(P1,8), pw3[1]=PKW(P1,10), pw3); \
    VRD(7); SBAR(); GAPA(C1=__builtin_amdgcn_mfma_f32_32x32x16_bf16(kf[7],qr[3],C1,0,0,0),   P1[14],P1[15],0.f,0.f,       pw3[2]=PKW(P1,12),pw3[3]=PKW(P1,14), pw3); \
    l_reg+=sacc; \
    if(GK){DMA_K((t)+3,sl_cur);} if(GV){DMA_V((t)+1,sl_next);} \
    _Pragma("unroll") for(int r=0;r<16;++r){C0[r]-=mhat;C1[r]-=mhat;} \
    CMASK(C0,C1,t); \
    { float a=MX3(C0[0],C0[1],C1[0]),b=MX3(C0[2],C0[3],C1[1]); a=MX3(a,C1[2],C1[3]); \
      _Pragma("unroll") for(int r=4;r<16;r+=4){a=MX3(a,C0[r],C0[r+1]);b=MX3(b,C0[r+2],C0[r+3]);a=MX3(a,C1[r],C1[r+1]);b=MX3(b,C1[r+2],C1[r+3]);} \
      float rm=__builtin_fmaxf(a,b); { auto rr=__builtin_amdgcn_permlane32_swap(__float_as_uint(rm),__float_as_uint(rm),false,false); rm=__builtin_fmaxf(__uint_as_float(rr[0]),__uint_as_float(rr[1])); } \
      resc=false; \
      if(__builtin_expect(__any(rm>(float)THRL),0)){ const float dl=__builtin_fmaxf(rm,0.f); mhat+=dl; \
        _Pragma("unroll") for(int r=0;r<16;++r){C0[r]-=dl;C1[r]-=dl;} \
        const float f=__builtin_amdgcn_exp2f(-dl); l_reg*=f; if(hi==0)wsf[r32]=f; resc=true; } } \
    SBAR(); \
    GAPB(o[0]=__builtin_amdgcn_mfma_f32_32x32x16_bf16(PAF(0),VFR(0),o[0],0,0,0), C0,0); \
    GAPB(o[1]=__builtin_amdgcn_mfma_f32_32x32x16_bf16(PAF(0),VFR(4),o[1],0,0,0), C0,4); \
    KRD(GL,0); GAPB(o[0]=__builtin_amdgcn_mfma_f32_32x32x16_bf16(PAF(1),VFR(1),o[0],0,0,0), C0,8); \
    KRD(GL,1); GAPB(o[1]=__builtin_amdgcn_mfma_f32_32x32x16_bf16(PAF(1),VFR(5),o[1],0,0,0), C0,12); \
    KRD(GL,2); GAPB(o[0]=__builtin_amdgcn_mfma_f32_32x32x16_bf16(PAF(2),VFR(2),o[0],0,0,0), C1,0); \
    KRD(GL,3); GAPB(o[1]=__builtin_amdgcn_mfma_f32_32x32x16_bf16(PAF(2),VFR(6),o[1],0,0,0), C1,4); \
    GAPB(o[0]=__builtin_amdgcn_mfma_f32_32x32x16_bf16(PAF(3),VFR(3),o[0],0,0,0), C1,8); \
    GAPB(o[1]=__builtin_amdgcn_mfma_f32_32x32x16_bf16(PAF(3),VFR(7),o[1],0,0,0), C1,12); \
    }while(0)
  int t=1;
  #undef CMASK
  #define CMASK(P0,P1,t) do{}while(0)
  for(;t+5<NT;t+=2){
    STEP(pB0,pB1,pA0,pA1,t,true,true,true);     WAIT_BAR(2); RESC(); ROT();
    STEP(pA0,pA1,pB0,pB1,t+1,true,true,true);   WAIT_BAR(2); RESC(); ROT();
  }
  #undef CMASK
  #define CMASK(P0,P1,t) do{int jb_=(t)-(NT-4); if(jb_>=0)cmask(P0,P1,jb_,qrel,hi);}while(0)
  #define ENDW(tt) do{ if((tt)+3<NT){WAIT_BAR(2);} else if((tt)+2<NT){WAIT_BAR(1);} else {WAIT_BAR(0);} }while(0)
  for(;t+1<NT;t+=2){
    STEP(pB0,pB1,pA0,pA1,t,(t+3<NT),(t+1<NT),(t+1<NT));       ENDW(t);   RESC(); ROT();
    STEP(pA0,pA1,pB0,pB1,t+1,(t+4<NT),(t+2<NT),(t+2<NT));     ENDW(t+1); RESC(); ROT();
  }
  STEP(pB0,pB1,pA0,pA1,NT-1,false,false,false); RESC();
  { float sacc=pB0[0]+pB0[1]; _Pragma("unroll") for(int r=2;r<16;++r)sacc+=pB0[r]; _Pragma("unroll") for(int r=0;r<16;++r)sacc+=pB1[r]; l_reg+=sacc;
    pw0=(u32x4){PKW(pB0,0),PKW(pB0,2),PKW(pB0,4),PKW(pB0,6)};pw1=(u32x4){PKW(pB0,8),PKW(pB0,10),PKW(pB0,12),PKW(pB0,14)};pw2=(u32x4){PKW(pB1,0),PKW(pB1,2),PKW(pB1,4),PKW(pB1,6)};pw3=(u32x4){PKW(pB1,8),PKW(pB1,10),PKW(pB1,12),PKW(pB1,14)};
    SBAR(); pv(o,vb0+sl_cur,PAF(0),PAF(1),PAF(2),PAF(3)); }
  #undef PKW
  #undef PAF
  #undef VFR
  #undef PIN
  #undef MX3
  #undef GAPA
  #undef GAPB
  #undef EX
  #undef VRD
  #undef KRD
  #undef STEP
  #undef ENDW
  {auto rr=__builtin_amdgcn_permlane32_swap(__float_as_uint(l_reg),__float_as_uint(l_reg),false,false);l_reg=__uint_as_float(rr[0])+__uint_as_float(rr[1]);}
  if(hi==0)wsf[32+r32]=l_reg;asm volatile("s_waitcnt lgkmcnt(0)":::"memory");
  float rli[16];
  #pragma unroll
  for(int r=0;r<16;++r)rli[r]=__builtin_amdgcn_rcpf(wsf[32+crow(r,hi)]);
  bf16*Ow=O+(rowbase+q0+wid*QBLK)*DM+oc;
  { bf16*stg=(bf16*)(shm+LDS_OST)+wid*2048;
    #pragma unroll
    for(int r=0;r<16;++r){const int orow=crow(r,hi);
      #pragma unroll
      for(int d0=0;d0<2;++d0)stg[orow*64+d0*32+r32]=__float2bfloat16(o[d0][r]*rli[r]);}
    asm volatile("s_waitcnt lgkmcnt(0)":::"memory");
    #pragma unroll
    for(int i=0;i<4;++i){const int row=i*8+(lane>>3),ch=lane&7; const u32x4 v=*(const u32x4*)(stg+row*64+ch*8); ATTN_STORE16(Ow+(long)row*DM+ch*8,v);} }
  asm volatile("s_waitcnt lgkmcnt(0)\n\ts_barrier":::"memory");
  #undef DMA_K
  #undef DMA_V
  #undef CMASK
  #undef START
  #undef RESC
  #undef ROT
}
constexpr int ATTN_LDS_BYTES=LDS_BYTES;
#undef SBAR
#undef WAIT_BAR
}

namespace attn_body {
struct AttnTensors { const bf16* Q; const bf16* K; const bf16* V; bf16* O; bf16* O2; };
struct AttnUnit { int bh; int qb; };
struct StaticOrder {
  int vcu;
  __device__ __forceinline__ explicit StaticOrder(int v):vcu(v){}
  __device__ __forceinline__ bool next(int i,AttnUnit&u)const{ if(i>=16)return false; const int s=vcu&7; u.bh=vcu; u.qb=(((i&1)?15-(i>>1):(i>>1))+s)&15; return true; }
};
template<class Sched,int THRL=8> __device__ __forceinline__ void attn_phase(char*lds,const AttnTensors&T,const Sched&S){
  AttnUnit u;
  for(int i=0;S.next(i,u);++i){ const int vv=u.bh, bhh=vv>>2, c=(vv>>1)&1, vh=vv&1, b=bhh>>3, h=bhh&7; attn_unit<THRL>(b,h*128+c*64,h*128+c*64,h*128+vh*64,h*128+vh*64,u.qb,T.Q,T.K,T.V,c?T.O2:T.O,lds); }
}
}

#define DI __device__ __forceinline__
#define LAS __attribute__((address_space(3)))
typedef unsigned short bf16_t;
typedef short bf16x8 __attribute__((ext_vector_type(8)));
typedef float f32x4 __attribute__((ext_vector_type(4)));
typedef float f32x16 __attribute__((ext_vector_type(16)));
typedef unsigned u32x4 __attribute__((ext_vector_type(4)));
typedef unsigned u32x2 __attribute__((ext_vector_type(2)));

constexpr int T_TOK = 32768, DM = 1024, SEQ = 4096, NB = 8;
constexpr size_t UNIT = (size_t)64 << 20, MiB = (size_t)1 << 20;
constexpr float EPS = 1e-6f;
constexpr int NTHR = 512;
constexpr int LDS_BYTES = 147456;
constexpr size_t WS_Q = 0, WS_K = UNIT, WS_V = 2 * UNIT, WS_Z = 3 * UNIT, WS_MVT = 5 * UNIT, WS_XN = 6 * UNIT, WS_MISC = 7 * UNIT;
constexpr size_t WS_Y0 = 0;
constexpr size_t WS_U = 0, WS_SZ = 2 * UNIT, WS_VT1 = 4 * UNIT, WS_Y1 = 2 * UNIT;
constexpr size_t MS_WT1 = WS_MISC, MS_WO0 = WS_MISC + 16 * MiB, MS_WUZ = WS_MISC + 20 * MiB, MS_WV = WS_MISC + 28 * MiB, MS_WO1 = WS_MISC + 32 * MiB;
constexpr size_t MS_GI = WS_MISC + 36 * MiB, MS_GF = MS_GI + 512 * 1024;
constexpr size_t MS_BCUM = WS_MISC + 37 * MiB, MS_A = MS_BCUM + 512 * 1024, MS_PM = MS_A + 512 * 1024, MS_WGT = MS_PM + 512 * 1024;
constexpr size_t MS_MPREV = WS_MISC + 39 * MiB, MS_DECAY = MS_MPREV + 4096, MS_DN = WS_MISC + 39 * MiB + 512 * 1024;
constexpr size_t MS_RSQ = WS_MISC + 40 * MiB, MS_CSQ = WS_MISC + 42 * MiB;
constexpr size_t WS_NEED = 8 * UNIT;

struct Params { const float* in[22]; float* out; unsigned char* ws; };

DI unsigned f2bf(float f) { unsigned u = __builtin_bit_cast(unsigned, f); return (u + 0x7fffu + ((u >> 16) & 1u)) >> 16; }
DI unsigned pk2(float lo, float hi) { return pg8::cvt_pk_bf16(lo, hi); }
DI float bflo(unsigned w) { return __builtin_bit_cast(float, w << 16); }
DI float bfhi(unsigned w) { return __builtin_bit_cast(float, w & 0xffff0000u); }
DI float bf2f(bf16_t h) { return __builtin_bit_cast(float, (unsigned)h << 16); }
DI void unpack8(const u32x4 w, float (&f)[8]) { f[0] = bflo(w.x); f[1] = bfhi(w.x); f[2] = bflo(w.y); f[3] = bfhi(w.y); f[4] = bflo(w.z); f[5] = bfhi(w.z); f[6] = bflo(w.w); f[7] = bfhi(w.w); }
DI u32x4 pack8(const float (&f)[8]) { u32x4 w; w.x = pk2(f[0], f[1]); w.y = pk2(f[2], f[3]); w.z = pk2(f[4], f[5]); w.w = pk2(f[6], f[7]); return w; }
DI float wave_sum(float v) {
#pragma unroll
    for (int o = 1; o < 64; o <<= 1) v += __shfl_xor(v, o);
    return v;
}
DI float silu_f(float x) { return x * __builtin_amdgcn_rcpf(1.0f + __builtin_amdgcn_exp2f(x * -1.4426950408889634f)); }
DI float sigmoid_f(float x) { return __builtin_amdgcn_rcpf(1.0f + __builtin_amdgcn_exp2f(x * -1.4426950408889634f)); }
DI int crow(int r, int hi) { return (r & 3) + 8 * (r >> 2) + 4 * hi; }
#define MFMA32(a, b, c) __builtin_amdgcn_mfma_f32_32x32x16_bf16((a), (b), (c), 0, 0, 0)
#define LDS_WAIT() asm volatile("s_waitcnt lgkmcnt(0)" ::: "memory")

DI void tr_item(const float* W, int ldw, int col0, int ncols, int K, bf16_t* WT, LAS float* scr, int item, int lane) {
    const int nblk = ncols / 32, kb = item / nblk, nb = item % nblk, k0 = 64 * kb, n0 = 32 * nb;
#pragma unroll 8
    for (int i = 0; i < 32; ++i) { const int kk = 2 * i + (lane >> 5); scr[kk * 33 + (lane & 31)] = W[(size_t)(k0 + kk) * ldw + col0 + n0 + (lane & 31)]; }
    LDS_WAIT(); asm volatile("" ::: "memory");
    const int c = lane & 7;
#pragma unroll
    for (int j = 0; j < 4; ++j) { const int n = (lane >> 3) + 8 * j; const LAS float* s = scr + (8 * c) * 33 + n;
        u32x4 o; o.x = pk2(s[0 * 33], s[1 * 33]); o.y = pk2(s[2 * 33], s[3 * 33]); o.z = pk2(s[4 * 33], s[5 * 33]); o.w = pk2(s[6 * 33], s[7 * 33]);
        *(u32x4*)(WT + (size_t)(n0 + n) * K + k0 + 8 * c) = o; }
    LDS_WAIT(); asm volatile("" ::: "memory");
}
DI void p0_prologue(const Params& P, LAS unsigned char* lds, int vcu, int G) {
    const int tid = fresh_tid(), lane = tid & 63, wave = tid >> 6;
    LAS float* scr = (LAS float*)(lds + wave * 16384);
    const int gw = vcu * 8 + wave, NGW = G * 8;
    unsigned char* ws = P.ws;
    constexpr int I_SEG = 16 * 32, I_O = 32 * 32, I_L1 = 16 * 64;
    constexpr int NITEMS = 8 * I_SEG + I_O + 3 * I_L1 + I_O;
    for (int it = gw; it < NITEMS; it += NGW) {
        int r = it;
        if (r < 8 * I_SEG) { const int seg = r / I_SEG; r -= seg * I_SEG;
            const int col0 = seg < 5 ? seg * 1024 : (seg == 5 ? 6152 : (seg == 6 ? 7176 : 5120));
            tr_item(P.in[2], 8200, col0, 1024, 1024, (bf16_t*)(ws + MS_WT1) + (size_t)seg * 1024 * 1024, scr, r, lane); continue; }
        r -= 8 * I_SEG;
        if (r < I_O) { tr_item(P.in[13], 1024, 0, 1024, 2048, (bf16_t*)(ws + MS_WO0), scr, r, lane); continue; }
        r -= I_O;
        if (r < I_L1) { tr_item(P.in[16], 6144, 0, 2048, 1024, (bf16_t*)(ws + MS_WUZ), scr, r, lane); continue; }
        r -= I_L1;
        if (r < I_L1) { tr_item(P.in[16], 6144, 4096, 2048, 1024, (bf16_t*)(ws + MS_WUZ) + (size_t)2048 * 1024, scr, r, lane); continue; }
        r -= I_L1;
        if (r < I_L1) { tr_item(P.in[16], 6144, 2048, 2048, 1024, (bf16_t*)(ws + MS_WV), scr, r, lane); continue; }
        r -= I_L1;
        tr_item(P.in[20], 1024, 0, 1024, 2048, (bf16_t*)(ws + MS_WO1), scr, r, lane);
    }
    const float* x = P.in[0]; const float* pre_g = P.in[1]; const float* w_in = P.in[2];
    f32x4 g4[4], wg[4][4][2];
#pragma unroll
    for (int j = 0; j < 4; ++j) { g4[j] = *(const f32x4*)(pre_g + 4 * lane + 256 * j);
#pragma unroll
        for (int e = 0; e < 4; ++e) { const float* p = w_in + (size_t)(4 * lane + 256 * j + e) * 8200 + 6144; wg[j][e][0] = *(const f32x4*)p; wg[j][e][1] = *(const f32x4*)(p + 4); } }
    const f32x4 bi = *(const f32x4*)P.in[3], bff = *(const f32x4*)P.in[4];
    bf16_t* XN = (bf16_t*)(ws + WS_XN); float* gi = (float*)(ws + MS_GI); float* gf = (float*)(ws + MS_GF);
    for (int m = gw; m < T_TOK; m += NGW) {
        const f32x4* xr = (const f32x4*)(x + (size_t)m * DM) + lane;
        f32x4 v[4]; float ss = 0.f;
#pragma unroll
        for (int j = 0; j < 4; ++j) { v[j] = xr[64 * j]; ss += (v[j].x * v[j].x + v[j].y * v[j].y) + (v[j].z * v[j].z + v[j].w * v[j].w); }
        const float rstd = 1.0f / sqrtf(wave_sum(ss) * (1.f / DM) + EPS);
        unsigned long long* o8 = (unsigned long long*)(XN + (size_t)m * DM) + lane;
        f32x4 p0 = (f32x4){0.f, 0.f, 0.f, 0.f}, p1 = p0;
#pragma unroll
        for (int j = 0; j < 4; ++j) { const f32x4 xn = v[j] * rstd * g4[j];
            o8[64 * j] = (unsigned long long)pk2(xn.x, xn.y) | ((unsigned long long)pk2(xn.z, xn.w) << 32);
#pragma unroll
            for (int e = 0; e < 4; ++e) { p0 += xn[e] * wg[j][e][0]; p1 += xn[e] * wg[j][e][1]; } }
#pragma unroll
        for (int e = 0; e < 4; ++e) { p0[e] = wave_sum(p0[e]); p1[e] = wave_sum(p1[e]); }
        if (lane == 0) { *(f32x4*)(gi + (size_t)m * 4) = p0 + bi; *(f32x4*)(gf + (size_t)m * 4) = p1 + bff; }
    }
}

DI void gate_scan(const Params& P, LAS unsigned char* lds, int bh) {
    const int tid = fresh_tid(); const int b = bh >> 2, h = bh & 3;
    LAS float* lf = (LAS float*)lds; LAS float* ic = lf + 4096; LAS float* bc = ic + 4096; LAS float* aa = bc + 4096;
    LAS float* cbl = aa + 4096; LAS float* cgm = cbl + 32; LAS float* cmp = cgm + 32; LAS float* cmn = cmp + 32;
    unsigned char* ws = P.ws;
    const float* gi = (const float*)(ws + MS_GI); const float* gf = (const float*)(ws + MS_GF);
    for (int i = 0; i < 8; ++i) { const int pos = i * NTHR + tid; const size_t row = (size_t)b * SEQ + pos; const float f = gf[row * 4 + h];
        lf[pos] = fminf(f, 0.f) - log1pf(expf(-fabsf(f))); ic[pos] = gi[row * 4 + h]; }
    __syncthreads();
    for (int i = 0; i < 8; ++i) { const int pos = i * NTHR + tid; const int c0 = pos & ~127; float s = 0.f; for (int j = c0; j <= pos; ++j) s += lf[j]; bc[pos] = s; aa[pos] = ic[pos] - s; }
    __syncthreads();
    if (tid < 32) { const float bl = bc[tid * 128 + 127]; float gm = -INFINITY; for (int j = 0; j < 128; ++j) gm = fmaxf(gm, aa[tid * 128 + j]); cbl[tid] = bl; cgm[tid] = bl + gm; }
    __syncthreads();
    if (tid == 0) { float m = 0.f; float* mp = (float*)(ws + MS_MPREV) + bh * 32; float* dc = (float*)(ws + MS_DECAY) + bh * 32;
        for (int c = 0; c < 32; ++c) { cmp[c] = m; const float mn = fmaxf(cbl[c] + m, cgm[c]); const float de = expf(cbl[c] + m - mn); cmn[c] = mn; mp[c] = m; dc[c] = de; m = mn; } }
    __syncthreads();
    float* o_bc = (float*)(ws + MS_BCUM) + (size_t)bh * SEQ; float* o_a = (float*)(ws + MS_A) + (size_t)bh * SEQ; float* o_pm = (float*)(ws + MS_PM) + (size_t)bh * SEQ; float* o_w = (float*)(ws + MS_WGT) + (size_t)bh * SEQ;
    for (int i = 0; i < 8; ++i) { const int pos = i * NTHR + tid; const int c = pos >> 7; const float w = expf(cbl[c] + aa[pos] - cmn[c]); float pmx = cmp[c];
        for (int j = c * 128; j <= pos; ++j) pmx = fmaxf(pmx, aa[j]);
        o_bc[pos] = bc[pos]; o_a[pos] = aa[pos]; o_pm[pos] = pmx; o_w[pos] = w; }
    __syncthreads();
}

DI void conv8(const bf16_t* src, const float* cw, const float* cb, int b, int t, int ch, float (&o)[8]) {
    const f32x4 b0 = *(const f32x4*)(cb + ch), b1 = *(const f32x4*)(cb + ch + 4);
    float acc[8] = {b0.x, b0.y, b0.z, b0.w, b1.x, b1.y, b1.z, b1.w};
#pragma unroll
    for (int j = 0; j < 4; ++j) { const int tt = t - 3 + j;
        if (tt >= 0) { const u32x4 xw = *(const u32x4*)(src + ((size_t)b * SEQ + tt) * 1024 + ch); float xf[8]; unpack8(xw, xf);
            const f32x4 w0 = *(const f32x4*)(cw + j * 1024 + ch), w1 = *(const f32x4*)(cw + j * 1024 + ch + 4);
            acc[0] += w0.x * xf[0]; acc[1] += w0.y * xf[1]; acc[2] += w0.z * xf[2]; acc[3] += w0.w * xf[3];
            acc[4] += w1.x * xf[4]; acc[5] += w1.y * xf[5]; acc[6] += w1.z * xf[6]; acc[7] += w1.w * xf[7]; } }
#pragma unroll
    for (int e = 0; e < 8; ++e) o[e] = silu_f(acc[e]);
}

constexpr int KP = 136;
DI void mlstm_i_unit(const Params& P, LAS unsigned char* lds, int bh, int c) {
    const int tid = fresh_tid(), lane = tid & 63, w = tid >> 6, l32 = lane & 31, hi = lane >> 5;
    const int b = bh >> 2, h = bh & 3; const size_t tok0 = (size_t)b * SEQ + c * 128;
    unsigned char* ws = P.ws;
    const bf16_t* MQK = (const bf16_t*)P.out; const bf16_t* MVT = (const bf16_t*)(ws + WS_MVT);
    const float* wgt = (const float*)(ws + MS_WGT) + (size_t)bh * SEQ + c * 128;
    LAS bf16_t* KT = (LAS bf16_t*)lds;
    bf16x8 av[8]; { const bf16_t* vp = MVT + (size_t)(h * 256 + 32 * w + l32) * T_TOK + tok0 + 8 * hi;
#pragma unroll
        for (int ks = 0; ks < 8; ++ks) av[ks] = *(const bf16x8*)(vp + 16 * ks); }
    for (int i = 0; i < 4; ++i) { const int task = i * NTHR + tid, d8 = task & 15, s = task >> 4; float o[8];
        conv8(MQK, P.in[5], P.in[6], b, c * 128 + s, 512 + h * 128 + d8 * 8, o); const float wv = wgt[s];
#pragma unroll
        for (int e = 0; e < 8; ++e) KT[(d8 * 8 + e) * KP + s] = (bf16_t)f2bf(o[e] * wv); }
    __syncthreads();
    f32x16 acc[4];
#pragma unroll
    for (int db = 0; db < 4; ++db) { acc[db] = (f32x16){};
#pragma unroll
        for (int ks = 0; ks < 8; ++ks) { const bf16x8 bf = *(const LAS bf16x8*)(KT + (32 * db + l32) * KP + 16 * ks + 8 * hi); acc[db] = MFMA32(av[ks], bf, acc[db]); } }
    bf16_t* dst = (bf16_t*)(ws + WS_XN) + ((size_t)(bh * 32 + c) * 256) * 128;
#pragma unroll
    for (int db = 0; db < 4; ++db)
#pragma unroll
        for (int r = 0; r < 16; ++r) dst[(size_t)(32 * w + crow(r, hi)) * 128 + 32 * db + l32] = (bf16_t)f2bf(acc[db][r]);
    { const int d = tid >> 2, q = tid & 3; float s = 0.f;
        for (int j = 0; j < 32; ++j) s += bf2f(KT[d * KP + 32 * q + j]);
        s += __shfl_xor(s, 1); s += __shfl_xor(s, 2);
        if (q == 0) ((float*)(ws + MS_DN))[(size_t)(bh * 32 + c) * 128 + d] = s; }
    __syncthreads();
}

DI void mlstm_scan(const Params& P, int vcu, int G) {
    unsigned char* ws = P.ws; const float* decay = (const float*)(ws + MS_DECAY);
    for (int gid = vcu * NTHR + fresh_tid(); gid < 32 * 4096; gid += G * NTHR) {
        const int bh = gid >> 12, e8 = gid & 4095;
        bf16_t* p = (bf16_t*)(ws + WS_XN) + (size_t)bh * 32 * 32768 + (size_t)e8 * 8;
        float st[8] = {0.f, 0.f, 0.f, 0.f, 0.f, 0.f, 0.f, 0.f};
#pragma unroll 4
        for (int c = 0; c < 32; ++c) { const u32x4 v = *(const u32x4*)(p + (size_t)c * 32768); float f[8]; unpack8(v, f); const float de = decay[bh * 32 + c];
            *(u32x4*)(p + (size_t)c * 32768) = pack8(st);
#pragma unroll
            for (int e = 0; e < 8; ++e) st[e] = de * st[e] + f[e]; }
    }
    for (int gid = vcu * NTHR + fresh_tid(); gid < 32 * 128; gid += G * NTHR) {
        const int bh = gid >> 7, d = gid & 127; float* p = (float*)(ws + MS_DN) + (size_t)bh * 32 * 128 + d; float st = 0.f;
        for (int c = 0; c < 32; ++c) { const float v = p[c * 128]; p[c * 128] = st; st = decay[bh * 32 + c] * st + v; }
    }
}

constexpr int SP_F = 260;
DI void mlstm_out_unit(const Params& P, LAS unsigned char* lds, int bh, int c) {
    const int tid = fresh_tid(), lane = tid & 63, w = tid >> 6, l32 = lane & 31, hi = lane >> 5;
    const int b = bh >> 2, h = bh & 3; const size_t tok0 = (size_t)b * SEQ + c * 128;
    unsigned char* ws = P.ws;
    const bf16_t* MQK = (const bf16_t*)P.out; const bf16_t* MO = (const bf16_t*)((unsigned char*)P.out + UNIT);
    const bf16_t* MVT = (const bf16_t*)(ws + WS_MVT); bf16_t* Z = (bf16_t*)(ws + WS_Z);
    const bf16_t* CP = (const bf16_t*)(ws + WS_XN) + ((size_t)(bh * 32 + c) * 256) * 128;
    LAS bf16_t* QS = (LAS bf16_t*)lds; LAS bf16_t* KS = QS + 128 * KP; LAS bf16_t* SPm = KS + 128 * KP;
    LAS float* stage = (LAS float*)lds;
    LAS float* sm = (LAS float*)(lds + 133120);
    LAS float* s_a = sm; LAS float* s_pm = sm + 128; LAS float* s_bc = sm + 256; LAS float* s_n = sm + 384; LAS float* s_iw = sm + 512; LAS float* s_rd = sm + 640;
    const float mprev = ((const float*)(ws + MS_MPREV))[bh * 32 + c];
    bf16x8 cT[8], vT[8];
    { const bf16_t* cp = CP + (size_t)(32 * w + l32) * 128 + 8 * hi; const bf16_t* vp = MVT + (size_t)(h * 256 + 32 * w + l32) * T_TOK + tok0 + 8 * hi;
#pragma unroll
        for (int ks = 0; ks < 8; ++ks) { cT[ks] = *(const bf16x8*)(cp + 16 * ks); vT[ks] = *(const bf16x8*)(vp + 16 * ks); } }
    if (tid < 128) { const size_t o = (size_t)bh * SEQ + c * 128 + tid; s_a[tid] = ((const float*)(ws + MS_A))[o]; s_pm[tid] = ((const float*)(ws + MS_PM))[o]; s_bc[tid] = ((const float*)(ws + MS_BCUM))[o];
        s_n[tid] = ((const float*)(ws + MS_DN))[(size_t)(bh * 32 + c) * 128 + tid]; }
    for (int i = 0; i < 8; ++i) { const int task = i * NTHR + tid, g = task & 31, t = task >> 5; const bool isk = g >= 16; const int d8 = g & 15; float o[8];
        conv8(MQK, P.in[5], P.in[6], b, c * 128 + t, (isk ? 512 : 0) + h * 128 + d8 * 8, o);
        if (!isk) {
#pragma unroll
            for (int e = 0; e < 8; ++e) o[e] *= 0.08838834764831845f; }
        *(LAS u32x4*)((isk ? KS : QS) + t * KP + d8 * 8) = pack8(o); }
    __syncthreads();
    { const int tb = w & 3, sb0 = (w >> 2) * 2;
#pragma unroll
        for (int j = 0; j < 2; ++j) { const int sb = sb0 + j; f32x16 acc = (f32x16){};
            if (sb <= tb) {
#pragma unroll
                for (int ks = 0; ks < 8; ++ks) { const bf16x8 a = *(const LAS bf16x8*)(QS + (32 * tb + l32) * KP + 16 * ks + 8 * hi); const bf16x8 bb = *(const LAS bf16x8*)(KS + (32 * sb + l32) * KP + 16 * ks + 8 * hi); acc = MFMA32(a, bb, acc); } }
            const int s = 32 * sb + l32; const float as = s_a[s];
#pragma unroll
            for (int r = 0; r < 16; ++r) { const int t = 32 * tb + crow(r, hi); const float v = (s <= t) ? acc[r] * __expf(as - s_pm[t]) : 0.f; SPm[t * KP + s] = (bf16_t)f2bf(v); } } }
    __syncthreads();
    { const int t = tid >> 2, q = tid & 3; float s1 = 0.f, s2 = 0.f;
        for (int j = 0; j < 32; ++j) { s1 += bf2f(SPm[t * KP + 32 * q + j]); s2 += bf2f(QS[t * KP + 32 * q + j]) * s_n[32 * q + j]; }
        s1 += __shfl_xor(s1, 1); s1 += __shfl_xor(s1, 2); s2 += __shfl_xor(s2, 1); s2 += __shfl_xor(s2, 2);
        if (q == 0) { const float iw = __expf(mprev - s_pm[t]); const float den = s1 + iw * s2; const float lim = __expf(-(s_bc[t] + s_pm[t])); s_iw[t] = iw; s_rd[t] = 1.0f / fmaxf(fabsf(den), lim); } }
    __syncthreads();
    f32x16 acc[4];
#pragma unroll
    for (int tb = 0; tb < 4; ++tb) { acc[tb] = (f32x16){};
#pragma unroll
        for (int ks = 0; ks < 8; ++ks) { const bf16x8 a = *(const LAS bf16x8*)(QS + (32 * tb + l32) * KP + 16 * ks + 8 * hi); acc[tb] = MFMA32(a, cT[ks], acc[tb]); }
#pragma unroll
        for (int r = 0; r < 16; ++r) acc[tb][r] *= s_iw[32 * tb + crow(r, hi)];
#pragma unroll
        for (int ks = 0; ks < 8; ++ks) { if (ks < 2 * (tb + 1)) { const bf16x8 a = *(const LAS bf16x8*)(SPm + (32 * tb + l32) * KP + 16 * ks + 8 * hi); acc[tb] = MFMA32(a, vT[ks], acc[tb]); } }
#pragma unroll
        for (int r = 0; r < 16; ++r) acc[tb][r] *= s_rd[32 * tb + crow(r, hi)];
    }
    __syncthreads();
#pragma unroll
    for (int tb = 0; tb < 4; ++tb)
#pragma unroll
        for (int r = 0; r < 16; ++r) stage[(32 * tb + crow(r, hi)) * SP_F + 32 * w + l32] = acc[tb][r];
    __syncthreads();
    const float* hg = P.in[12];
    for (int i = 0; i < 8; ++i) { const int task = i * NTHR + tid, v8 = task & 31, t = task >> 5;
        const f32x4 h0 = *(const LAS f32x4*)(stage + t * SP_F + v8 * 8), h1 = *(const LAS f32x4*)(stage + t * SP_F + v8 * 8 + 4);
        float hv[8] = {h0.x, h0.y, h0.z, h0.w, h1.x, h1.y, h1.z, h1.w};
        const u32x4 ow = *(const u32x4*)(MO + (tok0 + t) * 1024 + h * 256 + v8 * 8); float of[8]; unpack8(ow, of);
        bf16_t* zp = Z + (tok0 + t) * 2048 + 1024 + h * 256 + v8 * 8; const u32x4 zw = *(const u32x4*)zp; float zf[8]; unpack8(zw, zf);
        float ss = 0.f;
#pragma unroll
        for (int e = 0; e < 8; ++e) { hv[e] *= sigmoid_f(of[e]); ss += hv[e] * hv[e]; }
        ss += __shfl_xor(ss, 1); ss += __shfl_xor(ss, 2); ss += __shfl_xor(ss, 4); ss += __shfl_xor(ss, 8); ss += __shfl_xor(ss, 16);
        const float rstd = 1.0f / sqrtf(ss * (1.f / 256.f) + EPS);
        const f32x4 g0 = *(const f32x4*)(hg + v8 * 8), g1 = *(const f32x4*)(hg + v8 * 8 + 4); const float gg[8] = {g0.x, g0.y, g0.z, g0.w, g1.x, g1.y, g1.z, g1.w};
        float y[8];
#pragma unroll
        for (int e = 0; e < 8; ++e) y[e] = hv[e] * rstd * gg[e] * silu_f(zf[e]);
        *(u32x4*)zp = pack8(y); }
    __syncthreads();
}

DI void da_combine(const Params& P, LAS unsigned char* lds, int vcu, int G) {
    const int tid = fresh_tid(), lane = tid & 63, wave = tid >> 6;
    LAS float* sl = (LAS float*)lds;
    if (wave == 0) { const float a = P.in[7][lane] * P.in[8][lane], bq = P.in[9][lane] * P.in[10][lane]; const float d1 = wave_sum(a), d2 = wave_sum(bq); if (lane == 0) sl[0] = expf(d1) - expf(d2) + 0.2f; }
    __syncthreads();
    const float lam = sl[0];
    unsigned char* ws = P.ws;
    const bf16_t* O1 = (const bf16_t*)P.out; const bf16_t* O2 = (const bf16_t*)((unsigned char*)P.out + UNIT); bf16_t* Z = (bf16_t*)(ws + WS_Z);
    float gg[16]; { const float* g = P.in[11] + (16 * lane & 127);
#pragma unroll
        for (int e = 0; e < 16; e += 4) { const f32x4 t = *(const f32x4*)(g + e); gg[e] = t.x * 0.8f; gg[e + 1] = t.y * 0.8f; gg[e + 2] = t.z * 0.8f; gg[e + 3] = t.w * 0.8f; } }
    const int gw = vcu * 8 + wave, NGW = G * 8;
    for (int m = gw; m < T_TOK; m += NGW) {
        const size_t o = (size_t)m * 1024 + 16 * lane; bf16_t* zp = Z + (size_t)m * 2048 + 16 * lane;
        float a[16], bq[16], z[16];
        { float t[8]; unpack8(*(const u32x4*)(O1 + o), t); for (int e = 0; e < 8; ++e) a[e] = t[e]; unpack8(*(const u32x4*)(O1 + o + 8), t); for (int e = 0; e < 8; ++e) a[8 + e] = t[e];
          unpack8(*(const u32x4*)(O2 + o), t); for (int e = 0; e < 8; ++e) bq[e] = t[e]; unpack8(*(const u32x4*)(O2 + o + 8), t); for (int e = 0; e < 8; ++e) bq[8 + e] = t[e];
          unpack8(*(const u32x4*)zp, t); for (int e = 0; e < 8; ++e) z[e] = t[e]; unpack8(*(const u32x4*)(zp + 8), t); for (int e = 0; e < 8; ++e) z[8 + e] = t[e]; }
        float ss = 0.f;
#pragma unroll
        for (int e = 0; e < 16; ++e) { a[e] -= lam * bq[e]; ss += a[e] * a[e]; }
        ss += __shfl_xor(ss, 1); ss += __shfl_xor(ss, 2); ss += __shfl_xor(ss, 4);
        const float rstd = 1.0f / sqrtf(ss * (1.f / 128.f) + EPS);
        float y0[8], y1[8];
#pragma unroll
        for (int e = 0; e < 8; ++e) { y0[e] = a[e] * rstd * gg[e] * silu_f(z[e]); y1[e] = a[8 + e] * rstd * gg[8 + e] * silu_f(z[8 + e]); }
        *(u32x4*)zp = pack8(y0); *(u32x4*)(zp + 8) = pack8(y1);
    }
}

template <bool XNOUT> DI void resid_rows(const float* base, const bf16_t* Y, const float* rsq, const float* post_g, const float* pre_g, float* outf, bf16_t* XN, int vcu, int G) {
    const int tid = fresh_tid(), lane = tid & 63, wave = tid >> 6;
    float pg[16], ng[16];
#pragma unroll
    for (int hf = 0; hf < 2; ++hf)
#pragma unroll
        for (int q = 0; q < 2; ++q) { const int col = hf * 512 + 8 * lane + 4 * q; const f32x4 t = *(const f32x4*)(post_g + col); pg[hf * 8 + q * 4] = t.x; pg[hf * 8 + q * 4 + 1] = t.y; pg[hf * 8 + q * 4 + 2] = t.z; pg[hf * 8 + q * 4 + 3] = t.w;
            if (XNOUT) { const f32x4 u = *(const f32x4*)(pre_g + col); ng[hf * 8 + q * 4] = u.x; ng[hf * 8 + q * 4 + 1] = u.y; ng[hf * 8 + q * 4 + 2] = u.z; ng[hf * 8 + q * 4 + 3] = u.w; } }
    const int gw = vcu * 8 + wave, NGW = G * 8;
    for (int m = gw; m < T_TOK; m += NGW) {
        float sq = rsq[(size_t)(lane & 15) * T_TOK + m]; sq += __shfl_xor(sq, 1); sq += __shfl_xor(sq, 2); sq += __shfl_xor(sq, 4); sq += __shfl_xor(sq, 8);
        const float rstd = 1.0f / sqrtf(sq * (1.f / 1024.f) + EPS);
        float hv[16]; float ss = 0.f;
#pragma unroll
        for (int hf = 0; hf < 2; ++hf) { const size_t o = (size_t)m * 1024 + hf * 512 + 8 * lane; float yf[8]; unpack8(*(const u32x4*)(Y + o), yf);
            const f32x4 b0 = *(const f32x4*)(base + o), b1 = *(const f32x4*)(base + o + 4); const float bb[8] = {b0.x, b0.y, b0.z, b0.w, b1.x, b1.y, b1.z, b1.w};
#pragma unroll
            for (int e = 0; e < 8; ++e) { const float v = bb[e] + yf[e] * rstd * pg[hf * 8 + e]; hv[hf * 8 + e] = v; ss += v * v; }
            *(f32x4*)(outf + o) = (f32x4){hv[hf * 8], hv[hf * 8 + 1], hv[hf * 8 + 2], hv[hf * 8 + 3]}; *(f32x4*)(outf + o + 4) = (f32x4){hv[hf * 8 + 4], hv[hf * 8 + 5], hv[hf * 8 + 6], hv[hf * 8 + 7]}; }
        if (XNOUT) { const float r2 = 1.0f / sqrtf(wave_sum(ss) * (1.f / 1024.f) + EPS);
#pragma unroll
            for (int hf = 0; hf < 2; ++hf) { float xo[8];
#pragma unroll
                for (int e = 0; e < 8; ++e) xo[e] = hv[hf * 8 + e] * r2 * ng[hf * 8 + e];
                *(u32x4*)(XN + (size_t)m * 1024 + hf * 512 + 8 * lane) = pack8(xo); } }
    }
}

DI void spatial_unit(const Params& P, LAS unsigned char* lds, int bc, int g) {
    const int tid = fresh_tid(), lane = tid & 63, w = tid >> 6, l32 = lane & 31, hi = lane >> 5;
    const size_t tok0 = (size_t)bc * 128;
    unsigned char* ws = P.ws;
    const bf16_t* VT = (const bf16_t*)(ws + WS_VT1); bf16_t* U = (bf16_t*)(ws + WS_U); const bf16_t* SZ = (const bf16_t*)(ws + WS_SZ);
    const float* csq = (const float*)(ws + MS_CSQ);
    LAS bf16_t* AW = (LAS bf16_t*)lds; LAS float* stage = (LAS float*)lds; LAS float* rs = (LAS float*)(lds + 133120);
    bf16x8 bv[8]; { const bf16_t* vp = VT + (size_t)(g * 256 + 32 * w + l32) * T_TOK + tok0 + 8 * hi;
#pragma unroll
        for (int ks = 0; ks < 8; ++ks) bv[ks] = *(const bf16x8*)(vp + 16 * ks); }
    if (tid < 128) { float s = 0.f; for (int p = 0; p < 16; ++p) s += csq[(size_t)p * T_TOK + tok0 + tid]; rs[tid] = 1.0f / sqrtf(s * (1.f / 2048.f) + EPS); }
    __syncthreads();
    const float* wsp = P.in[18] + (size_t)g * 128 * 128;
    for (int i = 0; i < 8; ++i) { const int task = i * NTHR + tid, s4 = task & 31, t = task >> 5; const f32x4 wv = *(const f32x4*)(wsp + t * 128 + s4 * 4); float o[4];
#pragma unroll
        for (int e = 0; e < 4; ++e) { const int s = s4 * 4 + e; o[e] = (s <= t) ? wv[e] * rs[s] : 0.f; }
        u32x2 pk; pk.x = pk2(o[0], o[1]); pk.y = pk2(o[2], o[3]); *(LAS u32x2*)(AW + t * KP + s4 * 4) = pk; }
    __syncthreads();
    f32x16 acc[4];
    const float gn = P.in[17][g * 256 + 32 * w + l32];
#pragma unroll
    for (int tb = 0; tb < 4; ++tb) { acc[tb] = (f32x16){};
#pragma unroll
        for (int ks = 0; ks < 8; ++ks) { if (ks < 2 * (tb + 1)) { const bf16x8 a = *(const LAS bf16x8*)(AW + (32 * tb + l32) * KP + 16 * ks + 8 * hi); acc[tb] = MFMA32(a, bv[ks], acc[tb]); } } }
    __syncthreads();
    const float* bsp = P.in[19] + g * 128;
#pragma unroll
    for (int tb = 0; tb < 4; ++tb)
#pragma unroll
        for (int r = 0; r < 16; ++r) { const int t = 32 * tb + crow(r, hi); stage[t * SP_F + 32 * w + l32] = acc[tb][r] * gn + bsp[t]; }
    __syncthreads();
    for (int i = 0; i < 8; ++i) { const int task = i * NTHR + tid, d8 = task & 31, t = task >> 5;
        const f32x4 h0 = *(const LAS f32x4*)(stage + t * SP_F + d8 * 8), h1 = *(const LAS f32x4*)(stage + t * SP_F + d8 * 8 + 4); const float vs[8] = {h0.x, h0.y, h0.z, h0.w, h1.x, h1.y, h1.z, h1.w};
        const size_t o = (tok0 + t) * 2048 + g * 256 + d8 * 8; float uf[8], zf[8]; unpack8(*(const u32x4*)(U + o), uf); unpack8(*(const u32x4*)(SZ + o), zf); float y[8];
#pragma unroll
        for (int e = 0; e < 8; ++e) y[e] = uf[e] * vs[e] * zf[e];
        *(u32x4*)(U + o) = pack8(y); }
    __syncthreads();
}

#ifndef PHM
#define PHM 0xFFFF
#endif
typedef const __attribute__((address_space(4))) Params* KParamsPtr;
DI KParamsPtr launder_kp(KParamsPtr p) { asm volatile("" : "+s"(p)); return p; }
DI Params load_params(KParamsPtr p) { Params r;
#pragma unroll
    for (int i = 0; i < 22; ++i) r.in[i] = p->in[i];
    r.out = p->out; r.ws = p->ws; return r; }
#define LOADP() const Params P = load_params(launder_kp(kp_)); unsigned char* const ws = P.ws; unsigned char* const ob = (unsigned char*)P.out; (void)ws; (void)ob
__global__ void __launch_bounds__(NTHR, 2) mega_fwd(Params Pk_unused) {
    KParamsPtr kp_ = (KParamsPtr)__builtin_amdgcn_kernarg_segment_ptr();
    extern __shared__ __attribute__((aligned(16))) unsigned char lds_raw[];
    LAS unsigned char* lds = (LAS unsigned char*)lds_raw;
    cg::grid_group grid = cg::this_grid();
    const int G = gridDim.x, bx = blockIdx.x;
    const int vcu = (G % 8 == 0) ? (bx % 8) * (G / 8) + bx / 8 : bx;
    typedef pg8::bf16_t pbf;

    if constexpr ((PHM >> 0) & 1) { LOADP();
    p0_prologue(P, lds, vcu, G);
    }
    grid.sync();
    if constexpr ((PHM >> 1) & 1) { LOADP();
    for (int bh = bx; bh < 32; bh += G) gate_scan(P, lds, bh);
    { pg8::Gemm g{(const pbf*)(ws + WS_XN), (const pbf*)(ws + MS_WT1), T_TOK, 7168, 1024, 1024, 1024}; pg8::StaticOrder S; S.init(T_TOK, 7168, G, bx);
      pg8::Epi1 E{ws, ob, attn_body::C2};
      pg8::gemm_phase<pg8::Epi1, pg8::StaticOrder, true, true>(lds, g, S, E); }
    { pg8::Gemm g{(const pbf*)(ws + MS_WT1) + (size_t)7168 * 1024, (const pbf*)(ws + WS_XN), 1024, T_TOK, 1024, 1024, 1024}; pg8::StaticOrder S; S.init(1024, T_TOK, G, bx);
      pg8::EpiT<0, false> E{(pbf*)(ws + WS_MVT), T_TOK, nullptr, T_TOK};
      pg8::gemm_phase<pg8::EpiT<0, false>, pg8::StaticOrder, true, true>(lds, g, S, E); }
    }
    grid.sync();
    if constexpr ((PHM >> 2) & 1) { LOADP();
    for (int u = vcu; u < 1024; u += G) mlstm_i_unit(P, lds, u >> 5, u & 31);
    }
    grid.sync();
    if constexpr ((PHM >> 3) & 1) { LOADP();
    mlstm_scan(P, vcu, G);
    }
    grid.sync();
    if constexpr ((PHM >> 4) & 1) { LOADP();
    for (int u = vcu; u < 1024; u += G) mlstm_out_unit(P, lds, u >> 5, u & 31);
    }
    grid.sync();
    if constexpr ((PHM >> 5) & 1) { LOADP();
    { const attn_body::AttnTensors AT{(const attn_body::bf16*)(ws + WS_Q), (const attn_body::bf16*)(ws + WS_K), (const attn_body::bf16*)(ws + WS_V), (attn_body::bf16*)(ob), (attn_body::bf16*)(ob + UNIT)};
      for (int v = vcu; v < 256; v += G) { const attn_body::StaticOrder S(v); attn_body::attn_phase<attn_body::StaticOrder>((char*)lds_raw, AT, S); } }
    }
    grid.sync();
    if constexpr ((PHM >> 6) & 1) { LOADP();
    da_combine(P, lds, vcu, G);
    }
    grid.sync();
    if constexpr ((PHM >> 7) & 1) { LOADP();
    { pg8::Gemm g{(const pbf*)(ws + WS_Z), (const pbf*)(ws + MS_WO0), T_TOK, 1024, 2048, 2048, 2048}; pg8::StaticOrder S; S.init(T_TOK, 1024, G, bx);
      pg8::EpiY E{(pbf*)(ws + WS_Y0), (float*)(ws + MS_RSQ), T_TOK};
      pg8::gemm_phase<pg8::EpiY, pg8::StaticOrder, true, true>(lds, g, S, E); }
    }
    grid.sync();
    if constexpr ((PHM >> 8) & 1) { LOADP();
    resid_rows<true>(P.in[0], (const bf16_t*)(ws + WS_Y0), (const float*)(ws + MS_RSQ), P.in[14], P.in[15], P.out, (bf16_t*)(ws + WS_XN), vcu, G);
    }
    grid.sync();
    if constexpr ((PHM >> 9) & 1) { LOADP();
    { pg8::Gemm g{(const pbf*)(ws + WS_XN), (const pbf*)(ws + MS_WUZ), T_TOK, 4096, 1024, 1024, 1024}; pg8::StaticOrder S; S.init(T_TOK, 4096, G, bx);
      pg8::EpiUZ E{(pbf*)(ws + WS_U), (pbf*)(ws + WS_SZ)};
      pg8::gemm_phase<pg8::EpiUZ, pg8::StaticOrder, true, true>(lds, g, S, E); }
    { pg8::Gemm g{(const pbf*)(ws + MS_WV), (const pbf*)(ws + WS_XN), 2048, T_TOK, 1024, 1024, 1024}; pg8::StaticOrder S; S.init(2048, T_TOK, G, bx);
      pg8::EpiT<1, true> E{(pbf*)(ws + WS_VT1), T_TOK, (float*)(ws + MS_CSQ), T_TOK};
      pg8::gemm_phase<pg8::EpiT<1, true>, pg8::StaticOrder, true, true>(lds, g, S, E); }
    }
    grid.sync();
    if constexpr ((PHM >> 10) & 1) { LOADP();
    for (int u = vcu; u < 2048; u += G) spatial_unit(P, lds, u >> 3, u & 7);
    }
    grid.sync();
    if constexpr ((PHM >> 11) & 1) { LOADP();
    { pg8::Gemm g{(const pbf*)(ws + WS_U), (const pbf*)(ws + MS_WO1), T_TOK, 1024, 2048, 2048, 2048}; pg8::StaticOrder S; S.init(T_TOK, 1024, G, bx);
      pg8::EpiY E{(pbf*)(ws + WS_Y1), (float*)(ws + MS_RSQ), T_TOK};
      pg8::gemm_phase<pg8::EpiY, pg8::StaticOrder, true, true>(lds, g, S, E); }
    }
    grid.sync();
    if constexpr ((PHM >> 12) & 1) { LOADP();
    resid_rows<false>(P.out, (const bf16_t*)(ws + WS_Y1), (const float*)(ws + MS_RSQ), P.in[21], nullptr, P.out, nullptr, vcu, G);
    }
}

extern "C" void kernel_launch(void* const* d_in, const int* in_sizes, int n_in, void* d_out, int out_size, void* d_ws, size_t ws_size, hipStream_t stream) {
    static int grid = 0;
    if (grid == 0) {
        if (n_in != 22 || ws_size < WS_NEED || out_size != T_TOK * DM) { fprintf(stderr, "kernel_launch: unexpected shapes (n_in %d, out %d, ws %zu)\n", n_in, out_size, ws_size); grid = -1; return; }
        int dev = 0, cus = 0, per_cu = 0;
        hipGetDevice(&dev); hipDeviceGetAttribute(&cus, hipDeviceAttributeMultiprocessorCount, dev);
        hipFuncSetAttribute((const void*)mega_fwd, hipFuncAttributeMaxDynamicSharedMemorySize, LDS_BYTES);
        if (hipOccupancyMaxActiveBlocksPerMultiprocessor(&per_cu, (const void*)mega_fwd, NTHR, LDS_BYTES) != hipSuccess || per_cu < 1) per_cu = 1;
        (void)hipGetLastError();
        grid = cus * 1;
        if (grid <= 0) grid = 256;
    }
    if (grid < 0) return;
    Params p{};
    for (int i = 0; i < 22; ++i) p.in[i] = (const float*)d_in[i];
    p.out = (float*)d_out; p.ws = (unsigned char*)d_ws;
    void* args[] = {&p};
    hipError_t e = hipLaunchCooperativeKernel((const void*)mega_fwd, dim3(grid), dim3(NTHR), args, LDS_BYTES, stream);
    if (e != hipSuccess) fprintf(stderr, "cooperative launch failed: %s (grid %d)\n", hipGetErrorString(e), grid);
}
```

```cpp
#include <hip/hip_runtime.h>
#include <hip/hip_cooperative_groups.h>
#include <cstdio>
#include <cstdint>
namespace cg = cooperative_groups;
__device__ __forceinline__ int fresh_tid() { int t = (int)threadIdx.x; asm volatile("" : "+v"(t)); return t; }
namespace pg8 {
#define PG8_LAS __attribute__((address_space(3)))
typedef unsigned short bf16_t;
typedef short bf16x8 __attribute__((ext_vector_type(8)));
typedef float f32x4 __attribute__((ext_vector_type(4)));
typedef unsigned u32x4 __attribute__((ext_vector_type(4)));
constexpr int BM = 256, BK = 64, HALF = 128, HTB = HALF * BK * 2  , STAGE_BYTES = 8 * HTB, NXCD = 8, WGM = 8;

__host__ __device__ __forceinline__ int lds_byte(int r, int c) { const int st = (r >> 4) * 2 + (c >> 5), rr = r & 15, cc = c & 31, ob = rr * 64 + cc * 2; return st * 1024 + (ob ^ (((ob >> 9) & 1) << 5)); }
__host__ __device__ __forceinline__ void stage_rc(int b, int& R, int& C) { const int st = b / 1024, sb = b % 1024, swz = sb ^ (((sb >> 9) & 1) << 5); R = (st >> 1) * 16 + swz / 64; C = (st & 1) * 32 + (swz % 64) / 2; }
__host__ __device__ __forceinline__ int perm32(int rho) { const int n = rho >> 4, i = rho & 15; return 8 * (i >> 2) + 4 * n + (i & 3); }

struct Unit { int pm, pn; };
struct Gemm { const bf16_t* A; const bf16_t* Bt; int M, N, K, lda, ldb; };

struct StaticOrder {
    int nM, nN, nwg, G, c;
    __host__ __device__ void init(int M, int N, int G_, int c_) { nM = M / BM; nN = N / BM; nwg = nM * nN; G = G_; c = c_; }
    __host__ __device__ bool next(int i, Unit& u) const {
        const long L = (long)i * G + c; if (L >= nwg) return false;
        int wgid = (int)L; { const int q = nwg / NXCD, r = nwg % NXCD, xcd = wgid % NXCD, off = wgid / NXCD; wgid = (xcd < r ? xcd * (q + 1) : r * (q + 1) + (xcd - r) * q) + off; }
        const int nig = WGM * nN, gid = wgid / nig, fm = gid * WGM, gsz = (nM - fm) < WGM ? (nM - fm) : WGM;
        u.pm = fm + ((wgid % nig) % gsz); u.pn = (wgid % nig) / gsz; return true;
    }
    __device__ __forceinline__ void a_ready(const Unit&) const {}
    __device__ __forceinline__ void done(const Unit&) const {}
};

__device__ __forceinline__ unsigned cvt_pk_bf16(float lo, float hi) { unsigned r; asm volatile("v_cvt_pk_bf16_f32 %0, %1, %2" : "=v"(r) : "v"(lo), "v"(hi)); return r; }
typedef float f32x2 __attribute__((ext_vector_type(2)));
__device__ __forceinline__ f32x2 gelu_pk(f32x2 v) {
    const f32x2 av = __builtin_elementwise_abs(v), d = av * 0.2316418882f + 1.0f;
    f32x2 t; t.x = __builtin_amdgcn_rcpf(d.x); t.y = __builtin_amdgcn_rcpf(d.y);
    f32x2 q = t * 0.5307027145f + (-0.7265760135f); q = q * t + 0.7107068705f; q = q * t + (-0.142248368f); q = q * t + 0.127414796f; q = q * t;
    const f32x2 s = (v * v) * (-0.72134752044f);
    f32x2 e; e.x = __builtin_amdgcn_exp2f(s.x); e.y = __builtin_amdgcn_exp2f(s.y);
    const f32x2 m = v * (q * e), r = v - m;
    f32x2 o; o.x = v.x < 0.f ? m.x : r.x; o.y = v.y < 0.f ? m.y : r.y; return o;
}

template <int ACT  > struct EpiBf16 {
    static constexpr bool PERM = true, AFTER_DRAIN = false; static_assert(ACT == 0 || ACT == 1, "EpiBf16: ACT is 0 (none) or 1 (gelu_pk)");
    bf16_t* O; int ldc; const float* bias; int split_cols; size_t split_stride; float scale0;
    __device__ __forceinline__ void operator()(const f32x4 (&acc)[2][2][4][2], const Unit& u, int wr, int wc, int fr, int fq) const {
        const int row0 = u.pm * BM + wr * 64 + fr; int colt = u.pn * BM; bf16_t* base = O;
        float sc = 1.f; if (split_cols) { const int t = colt / split_cols; base += (size_t)t * split_stride; colt -= t * split_cols; if (t == 0) sc = scale0; }
        const int col0 = colt + wc * 32 + 8 * fq, bcol0 = u.pn * BM + wc * 32 + 8 * fq;
        f32x4 bv[2][2];
#pragma unroll
        for (int bj = 0; bj < 2; ++bj)
#pragma unroll
            for (int n = 0; n < 2; ++n) bv[bj][n] = bias ? *(const f32x4*)(bias + bcol0 + bj * HALF + 4 * n) : (f32x4){0.f, 0.f, 0.f, 0.f};
#pragma unroll
        for (int ai = 0; ai < 2; ++ai)
#pragma unroll
            for (int m = 0; m < 4; ++m) { bf16_t* rowp = base + (size_t)(row0 + ai * HALF + m * 16) * ldc + col0;
#pragma unroll
                for (int bj = 0; bj < 2; ++bj) { f32x4 v0 = acc[ai][bj][m][0] + bv[bj][0], v1 = acc[ai][bj][m][1] + bv[bj][1];
                    if (ACT == 1) { f32x2 a = gelu_pk((f32x2){v0[0], v0[1]}), b = gelu_pk((f32x2){v0[2], v0[3]}), c = gelu_pk((f32x2){v1[0], v1[1]}), d = gelu_pk((f32x2){v1[2], v1[3]});
                        v0 = (f32x4){a.x, a.y, b.x, b.y}; v1 = (f32x4){c.x, c.y, d.x, d.y}; }
                    v0 = v0 * sc; v1 = v1 * sc; u32x4 w; w.x = cvt_pk_bf16(v0[0], v0[1]); w.y = cvt_pk_bf16(v0[2], v0[3]); w.z = cvt_pk_bf16(v1[0], v1[1]); w.w = cvt_pk_bf16(v1[2], v1[3]);
                    *(u32x4*)(rowp + bj * HALF) = w; } }
    }
};
template <class Epi, class Sched, bool ALIGN_EPI = false, bool SP2 = false>
__device__ __forceinline__ void gemm_phase(PG8_LAS unsigned char* lds, const Gemm g, const Sched& S, const Epi& E) {
    const int tid = fresh_tid(), wid = __builtin_amdgcn_readfirstlane(tid >> 6), lane = tid & 63, wr = wid >> 2, wc = wid & 3, fr = lane & 15, fq = lane >> 4;
    const int K = g.K, nt = K / BK;
    unsigned voffA[2], voffB[2];
#pragma unroll
    for (int i = 0; i < 2; ++i) { int R, C; stage_rc(tid * 16 + i * 8192, R, C); const int Rb = Epi::PERM ? ((R & ~31) + perm32(R & 31)) : R;
        voffA[i] = (unsigned)(R * g.lda + C) * 2u; voffB[i] = (unsigned)(Rb * g.ldb + C) * 2u; }
    const size_t kstep = (size_t)(BK * 2);
    const size_t hstepA = (size_t)HALF * g.lda * 2, hstepB = (size_t)HALF * g.ldb * 2;
    const size_t tstepA = 2 * hstepA, tstepB = 2 * hstepB;
    const unsigned ldsw = (unsigned)wid * 1024u;
    const int aoff = lds_byte(wr * 64 + fr, fq * 8), boff = lds_byte(wc * 32 + fr, fq * 8);
#define PG8_SA(b, h) (((b) * 2 + (h)) * HTB)
#define PG8_SB(b, h) ((4 + (b) * 2 + (h)) * HTB)
#define PG8_STAGE(bufoff, gbase, voff) do { _Pragma("unroll") for (int _i = 0; _i < 2; ++_i) \
        __builtin_amdgcn_global_load_lds((const unsigned*)((const char*)(gbase) + (voff)[_i]), (PG8_LAS unsigned*)(lds + (bufoff) + ldsw + _i * 8192), 16, 0, 0); } while (0)
#define PG8_LDA(dst, b, h) do { _Pragma("unroll") for (int m = 0; m < 4; ++m) _Pragma("unroll") for (int k = 0; k < 2; ++k) dst[m][k] = *(const PG8_LAS bf16x8*)(lds + PG8_SA(b, h) + aoff + m * 2048 + k * 1024); } while (0)
#define PG8_LDB(dst, b, h) do { _Pragma("unroll") for (int n = 0; n < 2; ++n) _Pragma("unroll") for (int k = 0; k < 2; ++k) dst[n][k] = *(const PG8_LAS bf16x8*)(lds + PG8_SB(b, h) + boff + n * 2048 + k * 1024); } while (0)
#define PG8_MMA(ai, bj, At, Bt) do { __builtin_amdgcn_s_setprio(1); _Pragma("unroll") for (int m = 0; m < 4; ++m) _Pragma("unroll") for (int n = 0; n < 2; ++n) _Pragma("unroll") for (int k = 0; k < 2; ++k) \
        acc[ai][bj][m][n] = __builtin_amdgcn_mfma_f32_16x16x32_bf16(Bt[n][k], At[m][k], acc[ai][bj][m][n], 0, 0, 0); __builtin_amdgcn_s_setprio(0); } while (0)
#define PG8_WAIT_V(n) asm volatile("s_waitcnt vmcnt(" #n ")" ::: "memory")
#define PG8_WAIT_L(n) asm volatile("s_waitcnt lgkmcnt(" #n ")" ::: "memory")
#define PG8_BAR __builtin_amdgcn_s_barrier()
#define PG8_SCHED __builtin_amdgcn_sched_barrier(0)
    Unit cur, nxt; int ui = 0;
    if (!S.next(0, cur)) return;
    f32x4 acc[2][2][4][2];
#pragma unroll
    for (int a = 0; a < 2; ++a)
#pragma unroll
        for (int b = 0; b < 2; ++b)
#pragma unroll
            for (int m = 0; m < 4; ++m)
#pragma unroll
                for (int n = 0; n < 2; ++n) acc[a][b][m][n] = (f32x4){0.f, 0.f, 0.f, 0.f};
    bf16x8 At[4][2], B0[2][2], B1[2][2];
    const char* cA = (const char*)g.A + (size_t)cur.pm * tstepA; const char* cB = (const char*)g.Bt + (size_t)cur.pn * tstepB;
    S.a_ready(cur);
    if constexpr (SP2) {
        PG8_STAGE(PG8_SB(0, 0), cB, voffB); PG8_STAGE(PG8_SB(0, 1), cB + hstepB, voffB); PG8_STAGE(PG8_SA(0, 0), cA, voffA); PG8_STAGE(PG8_SA(0, 1), cA + hstepA, voffA);
        if (wr == 1) PG8_BAR;
        PG8_WAIT_V(2); PG8_BAR;
        PG8_STAGE(PG8_SB(1, 0), cB + kstep, voffB); PG8_STAGE(PG8_SA(1, 0), cA + kstep, voffA); PG8_STAGE(PG8_SB(1, 1), cB + hstepB + kstep, voffB);
        PG8_WAIT_V(6); PG8_BAR;
    } else {
        PG8_STAGE(PG8_SB(0, 0), cB, voffB); PG8_STAGE(PG8_SA(0, 0), cA, voffA); PG8_STAGE(PG8_SB(0, 1), cB + hstepB, voffB); PG8_STAGE(PG8_SA(0, 1), cA + hstepA, voffA);
        if (wr == 1) PG8_BAR;
        PG8_WAIT_V(4); PG8_BAR;
        PG8_STAGE(PG8_SB(1, 0), cB + kstep, voffB); PG8_STAGE(PG8_SA(1, 0), cA + kstep, voffA); PG8_STAGE(PG8_SB(1, 1), cB + hstepB + kstep, voffB);
        PG8_WAIT_V(6); PG8_BAR;
    }
    for (;;) {
        const bool has_next = S.next(ui + 1, nxt);
        const char* nA = has_next ? (const char*)g.A + (size_t)nxt.pm * tstepA : cA; const char* nB = has_next ? (const char*)g.Bt + (size_t)nxt.pn * tstepB : cB;
        for (int t = 0; t < nt; t += 2) {
            const bool last = (t == nt - 2);
            const char* a1 = cA + (size_t)(t + 1) * kstep;
            const char* a2 = last ? nA : cA + (size_t)(t + 2) * kstep; const char* b2 = last ? nB : cB + (size_t)(t + 2) * kstep;
            const char* a3 = a2 + kstep; const char* b3 = b2 + kstep;
            if (last && has_next) S.a_ready(nxt);
            if constexpr (SP2) {
            PG8_LDB(B0, 0, 0); PG8_LDB(B1, 0, 1); PG8_SCHED; PG8_LDA(At, 0, 0); PG8_STAGE(PG8_SA(1, 1), a1 + hstepA, voffA);
            PG8_WAIT_V(8); PG8_WAIT_L(0); PG8_BAR; PG8_MMA(0, 0, At, B0); PG8_MMA(0, 1, At, B1); PG8_BAR; PG8_SCHED;
            PG8_LDA(At, 0, 1); PG8_STAGE(PG8_SB(0, 0), b2, voffB); PG8_STAGE(PG8_SB(0, 1), b2 + hstepB, voffB); PG8_STAGE(PG8_SA(0, 0), a2, voffA);
            PG8_WAIT_V(8); PG8_WAIT_L(0); PG8_BAR; PG8_MMA(1, 0, At, B0); PG8_MMA(1, 1, At, B1); PG8_BAR; PG8_SCHED;
            PG8_LDB(B0, 1, 0); PG8_LDB(B1, 1, 1); PG8_SCHED; PG8_LDA(At, 1, 0); PG8_STAGE(PG8_SA(0, 1), a2 + hstepA, voffA);
            PG8_WAIT_V(8); PG8_WAIT_L(0); PG8_BAR; PG8_MMA(0, 0, At, B0); PG8_MMA(0, 1, At, B1); PG8_BAR; PG8_SCHED;
            PG8_LDA(At, 1, 1); PG8_STAGE(PG8_SB(1, 0), b3, voffB); PG8_STAGE(PG8_SB(1, 1), b3 + hstepB, voffB); PG8_STAGE(PG8_SA(1, 0), a3, voffA);
            PG8_WAIT_V(8); PG8_WAIT_L(0); PG8_BAR; PG8_MMA(1, 0, At, B0); PG8_MMA(1, 1, At, B1); PG8_BAR; PG8_SCHED;
            } else {
            PG8_LDB(B0, 0, 0); PG8_SCHED; PG8_LDA(At, 0, 0); PG8_STAGE(PG8_SA(1, 1), a1 + hstepA, voffA);
            PG8_WAIT_L(8); PG8_BAR; PG8_WAIT_L(0); PG8_MMA(0, 0, At, B0); PG8_BAR; PG8_SCHED;
            PG8_LDB(B1, 0, 1); PG8_STAGE(PG8_SB(0, 0), b2, voffB);
            PG8_BAR; PG8_WAIT_L(0); PG8_MMA(0, 1, At, B1); PG8_BAR;
            PG8_LDA(At, 0, 1); PG8_STAGE(PG8_SA(0, 0), a2, voffA);
            PG8_BAR; PG8_WAIT_L(0); PG8_MMA(1, 0, At, B0); PG8_BAR; PG8_SCHED;
            PG8_STAGE(PG8_SB(0, 1), b2 + hstepB, voffB);
            PG8_WAIT_V(6); PG8_BAR; PG8_MMA(1, 1, At, B1); PG8_BAR;
            PG8_LDB(B0, 1, 0); PG8_SCHED; PG8_LDA(At, 1, 0); PG8_STAGE(PG8_SA(0, 1), a2 + hstepA, voffA);
            PG8_WAIT_L(8); PG8_BAR; PG8_WAIT_L(0); PG8_MMA(0, 0, At, B0); PG8_BAR; PG8_SCHED;
            PG8_LDB(B1, 1, 1); PG8_STAGE(PG8_SB(1, 0), b3, voffB);
            PG8_BAR; PG8_WAIT_L(0); PG8_MMA(0, 1, At, B1); PG8_BAR;
            PG8_LDA(At, 1, 1); PG8_STAGE(PG8_SA(1, 0), a3, voffA);
            PG8_BAR; PG8_WAIT_L(0); PG8_MMA(1, 0, At, B0); PG8_BAR; PG8_SCHED;
            PG8_STAGE(PG8_SB(1, 1), b3 + hstepB, voffB);
            PG8_WAIT_V(6); PG8_BAR; PG8_MMA(1, 1, At, B1); PG8_BAR;
            }
        }
        if constexpr (ALIGN_EPI) { if (wr == 0) PG8_BAR; }
        if constexpr (!Epi::AFTER_DRAIN) { E(acc, cur, wr, wc, fr, fq); S.done(cur); }
        if (!has_next) break;
#pragma unroll
        for (int a = 0; a < 2; ++a)
#pragma unroll
            for (int b = 0; b < 2; ++b)
#pragma unroll
                for (int m = 0; m < 4; ++m)
#pragma unroll
                    for (int n = 0; n < 2; ++n) acc[a][b][m][n] = (f32x4){0.f, 0.f, 0.f, 0.f};
        cur = nxt; cA = nA; cB = nB; ++ui;
        if constexpr (ALIGN_EPI) { if (wr == 1) PG8_BAR; }
    }
    PG8_WAIT_V(0);
    if constexpr (!ALIGN_EPI) { if (wr == 0) PG8_BAR; }
    PG8_BAR;
    if constexpr (Epi::AFTER_DRAIN) { E.fused(acc, cur, wr, wc, fr, fq, lds, wid, lane); S.done(cur); }
#undef PG8_SA
#undef PG8_SB
#undef PG8_STAGE
#undef PG8_LDA
#undef PG8_LDB
#undef PG8_MMA
#undef PG8_WAIT_V
#undef PG8_WAIT_L
#undef PG8_BAR
#undef PG8_SCHED
}
}
namespace pg8 {
__device__ __forceinline__ float act_gelu_tanh(float x) {
    const float u = x * (1.0f + 0.044715f * x * x) * (-2.0f * 0.7978845608028654f * 1.4426950408889634f);
    return x * __builtin_amdgcn_rcpf(1.0f + __builtin_amdgcn_exp2f(u));
}
__device__ __forceinline__ float act_silu(float x) { return x * __builtin_amdgcn_rcpf(1.0f + __builtin_amdgcn_exp2f(x * -1.4426950408889634f)); }
template <int ACT> __device__ __forceinline__ float act_apply(float x) { if (ACT == 1) return act_gelu_tanh(x); if (ACT == 2) return act_silu(x); return x; }

constexpr size_t UNIT = (size_t)64 << 20;

struct Epi1 {
    static constexpr bool PERM = true, AFTER_DRAIN = false;
    unsigned char* ws; unsigned char* outb; float qscale;
    __device__ __forceinline__ void operator()(const f32x4 (&acc)[2][2][4][2], const Unit& u, int wr, int wc, int fr, int fq) const {
        const int seg = u.pn >> 2; int colt = (u.pn & 3) * BM; int ldc = 1024; float sc = 1.f;
        unsigned char* bb = ws + (size_t)seg * UNIT;
        if (seg == 0) sc = qscale;
        if (seg == 3) { bb = ws + 3 * UNIT; ldc = 2048; }
        if (seg == 4) { bb = outb; }
        if (seg == 5) { bb = outb + UNIT; }
        if (seg == 6) { bb = ws + 3 * UNIT; ldc = 2048; colt += 1024; }
        bf16_t* base = (bf16_t*)bb;
        const int row0 = u.pm * BM + wr * 64 + fr, col0 = colt + wc * 32 + 8 * fq;
#pragma unroll
        for (int ai = 0; ai < 2; ++ai)
#pragma unroll
            for (int m = 0; m < 4; ++m) { bf16_t* rowp = base + (size_t)(row0 + ai * HALF + m * 16) * ldc + col0;
#pragma unroll
                for (int bj = 0; bj < 2; ++bj) { const f32x4 v0 = acc[ai][bj][m][0] * sc, v1 = acc[ai][bj][m][1] * sc;
                    u32x4 w; w.x = cvt_pk_bf16(v0[0], v0[1]); w.y = cvt_pk_bf16(v0[2], v0[3]); w.z = cvt_pk_bf16(v1[0], v1[1]); w.w = cvt_pk_bf16(v1[2], v1[3]);
                    *(u32x4*)(rowp + bj * HALF) = w; } }
    }
};
struct EpiUZ {
    static constexpr bool PERM = true, AFTER_DRAIN = false;
    bf16_t* U; bf16_t* SZ;
    __device__ __forceinline__ void operator()(const f32x4 (&acc)[2][2][4][2], const Unit& u, int wr, int wc, int fr, int fq) const {
        const bool isz = u.pn >= 8; bf16_t* base = isz ? SZ : U; const int colt = (u.pn & 7) * BM;
        const int row0 = u.pm * BM + wr * 64 + fr, col0 = colt + wc * 32 + 8 * fq;
#pragma unroll
        for (int ai = 0; ai < 2; ++ai)
#pragma unroll
            for (int m = 0; m < 4; ++m) { bf16_t* rowp = base + (size_t)(row0 + ai * HALF + m * 16) * 2048 + col0;
#pragma unroll
                for (int bj = 0; bj < 2; ++bj) { f32x4 v0 = acc[ai][bj][m][0], v1 = acc[ai][bj][m][1];
                    if (isz) {
#pragma unroll
                        for (int e = 0; e < 4; ++e) { v0[e] = act_silu(v0[e]); v1[e] = act_silu(v1[e]); }
                    } else {
#pragma unroll
                        for (int e = 0; e < 4; ++e) { v0[e] = act_gelu_tanh(v0[e]); v1[e] = act_gelu_tanh(v1[e]); }
                    }
                    u32x4 w; w.x = cvt_pk_bf16(v0[0], v0[1]); w.y = cvt_pk_bf16(v0[2], v0[3]); w.z = cvt_pk_bf16(v1[0], v1[1]); w.w = cvt_pk_bf16(v1[2], v1[3]);
                    *(u32x4*)(rowp + bj * HALF) = w; } }
    }
};
template <int ACT, bool CSQ> struct EpiT {
    static constexpr bool PERM = true, AFTER_DRAIN = false;
    bf16_t* O; int ldc; float* csq; int ntok;
    __device__ __forceinline__ void operator()(const f32x4 (&acc)[2][2][4][2], const Unit& u, int wr, int wc, int fr, int fq) const {
        const int row0 = u.pm * BM + wr * 64 + fr, col0 = u.pn * BM + wc * 32 + 8 * fq;
        f32x4 cs[2][2];
#pragma unroll
        for (int bj = 0; bj < 2; ++bj) { cs[bj][0] = (f32x4){0.f, 0.f, 0.f, 0.f}; cs[bj][1] = (f32x4){0.f, 0.f, 0.f, 0.f}; }
#pragma unroll
        for (int ai = 0; ai < 2; ++ai)
#pragma unroll
            for (int m = 0; m < 4; ++m) { bf16_t* rowp = O + (size_t)(row0 + ai * HALF + m * 16) * ldc + col0;
#pragma unroll
                for (int bj = 0; bj < 2; ++bj) { f32x4 v0 = acc[ai][bj][m][0], v1 = acc[ai][bj][m][1];
#pragma unroll
                    for (int e = 0; e < 4; ++e) { v0[e] = act_apply<ACT>(v0[e]); v1[e] = act_apply<ACT>(v1[e]); }
                    if (CSQ) { cs[bj][0] += v0 * v0; cs[bj][1] += v1 * v1; }
                    u32x4 w; w.x = cvt_pk_bf16(v0[0], v0[1]); w.y = cvt_pk_bf16(v0[2], v0[3]); w.z = cvt_pk_bf16(v1[0], v1[1]); w.w = cvt_pk_bf16(v1[2], v1[3]);
                    *(u32x4*)(rowp + bj * HALF) = w; } }
        if (CSQ) {
#pragma unroll
            for (int bj = 0; bj < 2; ++bj)
#pragma unroll
                for (int n = 0; n < 2; ++n) { f32x4 s = cs[bj][n];
#pragma unroll
                    for (int e = 0; e < 4; ++e) { float t = s[e]; t += __shfl_xor(t, 1); t += __shfl_xor(t, 2); t += __shfl_xor(t, 4); t += __shfl_xor(t, 8); s[e] = t; }
                    if (fr == 0) *(f32x4*)(csq + (size_t)(2 * u.pm + wr) * ntok + col0 + bj * HALF + 4 * n) = s; }
        }
    }
};
struct EpiY {
    static constexpr bool PERM = true, AFTER_DRAIN = false;
    bf16_t* O; float* rsq; int nrow;
    __device__ __forceinline__ void operator()(const f32x4 (&acc)[2][2][4][2], const Unit& u, int wr, int wc, int fr, int fq) const {
        const int row0 = u.pm * BM + wr * 64 + fr, col0 = u.pn * BM + wc * 32 + 8 * fq;
#pragma unroll
        for (int ai = 0; ai < 2; ++ai)
#pragma unroll
            for (int m = 0; m < 4; ++m) { const int row = row0 + ai * HALF + m * 16; bf16_t* rowp = O + (size_t)row * 1024 + col0; float s = 0.f;
#pragma unroll
                for (int bj = 0; bj < 2; ++bj) { const f32x4 v0 = acc[ai][bj][m][0], v1 = acc[ai][bj][m][1];
                    s += (v0[0] * v0[0] + v0[1] * v0[1]) + (v0[2] * v0[2] + v0[3] * v0[3]) + (v1[0] * v1[0] + v1[1] * v1[1]) + (v1[2] * v1[2] + v1[3] * v1[3]);
                    u32x4 w; w.x = cvt_pk_bf16(v0[0], v0[1]); w.y = cvt_pk_bf16(v0[2], v0[3]); w.z = cvt_pk_bf16(v1[0], v1[1]); w.w = cvt_pk_bf16(v1[2], v1[3]);
                    *(u32x4*)(rowp + bj * HALF) = w; }
                s += __shfl_xor(s, 16); s += __shfl_xor(s, 32);
                if (fq == 0) rsq[(size_t)(4 * u.pn + wc) * nrow + row] = s; }
    }
};
}
#include <hip/hip_bf16.h>
#include <cmath>
namespace attn_body {
using bf16=__hip_bfloat16;
using bf16x8=__attribute__((ext_vector_type(8)))short;
using s16x4=__attribute__((ext_vector_type(4)))short;
using f32x16=__attribute__((ext_vector_type(16)))float;
using u32x4=__attribute__((ext_vector_type(4)))unsigned;
constexpr int BATCH=8,NHEAD=16,SEQ=4096,D=64,DM=1024;
constexpr int NW=8,QBLK=32,QB=QBLK*NW,KVBLK=64,NQB=SEQ/QB;
constexpr int ATTN_PITCH=DM, ATTN_UNIT_ROWS=QB;
__device__ __forceinline__ int crow(int r,int hi){return (r&3)+8*(r>>2)+4*hi;}
#define SBAR() __builtin_amdgcn_sched_barrier(0)
__device__ __forceinline__ void cmask(f32x16&p0,f32x16&p1,int jb,int qrel,int hi){
  const float NEG=-INFINITY; int kb=64*jb+4*hi;
  #pragma unroll
  for(int r=0;r<16;++r){int kv=kb+(r&3)+8*(r>>2); if(kv>qrel)p0[r]=NEG; if(kv+32>qrel)p1[r]=NEG;}
}

constexpr int NSLOT=3, SLOTB=8192;
constexpr int LDS_K=0, LDS_V=NSLOT*SLOTB, LDS_WS=2*NSLOT*SLOTB, LDS_OST=LDS_WS+NW*64*4, LDS_BYTES=LDS_OST+NW*4096;
constexpr float C2=0.125f*1.4426950408889634f;
__device__ __forceinline__ void glds16(const void*gsrc,unsigned lds_dst){unsigned keep;
  asm volatile("s_mov_b32 %0, m0\n\ts_mov_b32 m0, %2\n\ts_nop 0\n\tglobal_load_lds_dwordx4 %1, off\n\ts_mov_b32 m0, %0":"=&s"(keep):"v"(gsrc),"s"(lds_dst):"memory");}
__device__ __forceinline__ float max3f(float a,float b,float c){float r;asm("v_max3_f32 %0, %1, %2, %3":"=v"(r):"v"(a),"v"(b),"v"(c));return r;}
__device__ __forceinline__ float max2f(float a,float b){float r;asm("v_max_f32_e32 %0, %1, %2":"=v"(r):"v"(a),"v"(b));return r;}
__device__ __forceinline__ float fadd_s(float a,float b){float r;asm("v_add_f32_e32 %0, %1, %2":"=v"(r):"v"(a),"v"(b));return r;}
__device__ __forceinline__ float fsub_s(float a,float b){float r;asm("v_sub_f32_e32 %0, %1, %2":"=v"(r):"v"(a),"v"(b));return r;}
typedef float f32x2_t __attribute__((ext_vector_type(2))); typedef __bf16 bf16x2_t __attribute__((ext_vector_type(2)));
__device__ __forceinline__ unsigned cvtpk_s(float lo,float hi){f32x2_t v={lo,hi};bf16x2_t b=__builtin_convertvector(v,bf16x2_t);return __builtin_bit_cast(unsigned,b);}
#define WAIT_BAR(N) asm volatile("s_waitcnt vmcnt(" #N ") lgkmcnt(0)\n\ts_barrier":::"memory")

__device__ __forceinline__ void qkt(f32x16&p0,f32x16&p1,const char*Kslot,const bf16x8*qr,const f32x16&negm,int r32,int hi){
  const char*kb=Kslot+hi*1024+r32*16;
  #pragma unroll
  for(int d0=0;d0<4;++d0){
    const bf16x8 b0=*reinterpret_cast<const bf16x8*>(kb+d0*2048);
    const bf16x8 b1=*reinterpret_cast<const bf16x8*>(kb+d0*2048+512);
    if(d0==0){p0=__builtin_amdgcn_mfma_f32_32x32x16_bf16(b0,qr[0],negm,0,0,0);p1=__builtin_amdgcn_mfma_f32_32x32x16_bf16(b1,qr[0],negm,0,0,0);}
    else{p0=__builtin_amdgcn_mfma_f32_32x32x16_bf16(b0,qr[d0],p0,0,0,0);p1=__builtin_amdgcn_mfma_f32_32x32x16_bf16(b1,qr[d0],p1,0,0,0);}}
}
typedef __attribute__((address_space(3))) const char* lds_cptr;
typedef short v4i16_t __attribute__((ext_vector_type(4)));
__device__ __forceinline__ void kload8(bf16x8*kf,lds_cptr kp){
  kf[0]=*(const __attribute__((address_space(3))) bf16x8*)(kp);      kf[1]=*(const __attribute__((address_space(3))) bf16x8*)(kp+512);
  kf[2]=*(const __attribute__((address_space(3))) bf16x8*)(kp+2048); kf[3]=*(const __attribute__((address_space(3))) bf16x8*)(kp+2560);
  kf[4]=*(const __attribute__((address_space(3))) bf16x8*)(kp+4096); kf[5]=*(const __attribute__((address_space(3))) bf16x8*)(kp+4608);
  kf[6]=*(const __attribute__((address_space(3))) bf16x8*)(kp+6144); kf[7]=*(const __attribute__((address_space(3))) bf16x8*)(kp+6656);
}
__device__ __forceinline__ void kload2(bf16x8*kf,lds_cptr kp,int j){ kf[2*j]=*(const __attribute__((address_space(3))) bf16x8*)(kp+j*2048); kf[2*j+1]=*(const __attribute__((address_space(3))) bf16x8*)(kp+j*2048+512); }
__device__ __forceinline__ s16x4 vtr(lds_cptr p){ return __builtin_bit_cast(s16x4,__builtin_amdgcn_ds_read_tr16_b64_v4i16((__attribute__((address_space(3))) v4i16_t*)p)); }
__device__ __forceinline__ float rowmax(const f32x16&p0,const f32x16&p1){
  float a=max3f(p0[0],p0[1],p1[0]),b=max3f(p0[2],p0[3],p1[1]);a=max3f(a,p1[2],p1[3]);
  #pragma unroll
  for(int r=4;r<16;r+=4){a=max3f(a,p0[r],p0[r+1]);b=max3f(b,p0[r+2],p0[r+3]);a=max3f(a,p1[r],p1[r+1]);b=max3f(b,p1[r+2],p1[r+3]);}
  const float m=max2f(a,b);
  auto rr=__builtin_amdgcn_permlane32_swap(__float_as_uint(m),__float_as_uint(m),false,false);
  return max2f(__uint_as_float(rr[0]),__uint_as_float(rr[1]));
}
__device__ __forceinline__ void pv(f32x16*o,int vb,bf16x8 pa0,bf16x8 pa1,bf16x8 pa2,bf16x8 pa3){
  #pragma unroll
  for(int d0=0;d0<2;++d0){s16x4 lo[4],hi[4];
    #pragma unroll
    for(int ks=0;ks<4;++ks){
      asm volatile("ds_read_b64_tr_b16 %0,%1 offset:%c2":"=&v"(lo[ks]):"v"(vb),"i"(d0*4096+ks*1024):"memory");
      asm volatile("ds_read_b64_tr_b16 %0,%1 offset:%c2":"=&v"(hi[ks]):"v"(vb),"i"(d0*4096+ks*1024+512):"memory");}
    asm volatile("s_waitcnt lgkmcnt(0)":::"memory");SBAR();
    #define PK(k) (bf16x8){lo[k][0],lo[k][1],lo[k][2],lo[k][3],hi[k][0],hi[k][1],hi[k][2],hi[k][3]}
    o[d0]=__builtin_amdgcn_mfma_f32_32x32x16_bf16(pa0,PK(0),o[d0],0,0,0);
    o[d0]=__builtin_amdgcn_mfma_f32_32x32x16_bf16(pa1,PK(1),o[d0],0,0,0);
    o[d0]=__builtin_amdgcn_mfma_f32_32x32x16_bf16(pa2,PK(2),o[d0],0,0,0);
    o[d0]=__builtin_amdgcn_mfma_f32_32x32x16_bf16(pa3,PK(3),o[d0],0,0,0);
    #undef PK
  }
}

#ifndef ATTN_STORE16
#define ATTN_STORE16(p,v) (*(u32x4*)(p)=(v))
#endif
template<int THRL> __device__ __forceinline__ void attn_unit(int b,int qc,int kc,int vc,int oc,int qb,const bf16*Q,const bf16*__restrict__ K,const bf16*__restrict__ V,bf16*O,char*shm){
  const int tid=fresh_tid(),lane=tid&63,r32=lane&31,hi=lane>>5; const int wid=__builtin_amdgcn_readfirstlane(tid>>6);
  const long rowbase=(long)b*SEQ; const int q0=qb*QB;
  const bf16*Qw=Q+(rowbase+q0+wid*QBLK)*DM+qc;
  const bf16*Kh=K+rowbase*DM+kc,*Vh=V+rowbase*DM+vc;
  const unsigned lds0=(unsigned)(uintptr_t)shm;
  float*wsf=(float*)(shm+LDS_WS)+wid*64;
  const bf16*ksrc=Kh+(long)lane*DM+wid*8;
  const bf16*vsrc=Vh+(long)(16*(wid&3)+(lane>>2))*DM+(wid>>2)*32+(lane&3)*8;
  const unsigned kdst=lds0+LDS_K+wid*1024, vdst=lds0+LDS_V+wid*1024;
  #define DMA_K(t,slot) glds16(ksrc+(long)(t)*KVBLK*DM,(unsigned)__builtin_amdgcn_readfirstlane(kdst+(slot)))
  #define DMA_V(t,slot) glds16(vsrc+(long)(t)*KVBLK*DM,(unsigned)__builtin_amdgcn_readfirstlane(vdst+(slot)))
  const int vb0=(int)(lds0+LDS_V)+((lane>>4)&1)*32+(lane&3)*8+(4*hi+((lane&15)>>2))*64;
  const char*Kbase=shm+LDS_K; bf16x8 kf[8];
  const lds_cptr shm3=(lds_cptr)shm; const lds_cptr kp0=shm3+LDS_K+hi*1024+r32*16; const lds_cptr vp0=shm3+LDS_V+((lane>>4)&1)*32+(lane&3)*8+(4*hi+((lane&15)>>2))*64;
  const int NT=(q0+QB)/KVBLK;
  DMA_K(0,0);DMA_V(0,0);DMA_K(1,SLOTB);
  bf16x8 qr[4];
  #pragma unroll
  for(int d0=0;d0<4;++d0)qr[d0]=*reinterpret_cast<const bf16x8*>(&Qw[(long)r32*DM+d0*16+hi*8]);
  float mhat=0.f,l_reg=0.f;f32x16 o[2];o[0]=f32x16{};o[1]=f32x16{};const f32x16 zero16=f32x16{};
  const int qrel=wid*QBLK+r32;
  #define CMASK(P0,P1,t) do{int jb_=(t)-(NT-4); if(jb_>=0)cmask(P0,P1,jb_,qrel,hi);}while(0)
  bool resc=false;
  #define START(P0,P1) do{ const float rm=rowmax(P0,P1); resc=false; \
    { const float dl=rm; mhat=fadd_s(mhat,dl); \
      _Pragma("unroll") for(int r=0;r<16;++r){P0[r]=fsub_s(P0[r],dl);P1[r]=fsub_s(P1[r],dl);} \
      } \
    _Pragma("unroll") for(int r=0;r<16;++r)P0[r]=__builtin_amdgcn_exp2f(P0[r]); }while(0)
  #define RESC() do{ if(resc){ asm volatile("s_waitcnt lgkmcnt(0)":::"memory"); \
      _Pragma("unroll") for(int d_=0;d_<2;++d_) _Pragma("unroll") for(int r=0;r<16;++r)o[d_][r]*=wsf[crow(r,hi)]; } }while(0)
  f32x16 pA0,pA1,pB0,pB1;
  int sl_prev=0,sl_cur=0,sl_next=SLOTB;
  #define ROT() do{sl_prev=sl_cur;sl_cur=sl_next;sl_next=(sl_next==(NSLOT-1)*SLOTB)?0:sl_next+SLOTB;}while(0)
  DMA_K(2,2*SLOTB);
  WAIT_BAR(3);
  qkt(pA0,pA1,Kbase,qr,zero16,r32,hi);asm volatile("s_nop 15\n\ts_nop 7":"+v"(pA0),"+v"(pA1));CMASK(pA0,pA1,0);
  START(pA0,pA1);
  _Pragma("unroll") for(int r=0;r<16;++r)pA1[r]=__builtin_amdgcn_exp2f(pA1[r]);
  WAIT_BAR(0);
  DMA_K(3,0);DMA_V(1,SLOTB);
  ROT();
  kload8(kf,kp0+sl_cur);
  WAIT_BAR(2);
  s16x4 vlo[8],vhi[8]; u32x4 pw0,pw1,pw2,pw3;
  #define PKW(P,B) cvtpk_s(P[B],P[B+1])
  #define PAF(k) __builtin_bit_cast(bf16x8,pw##k)
  #define VFR(i) (bf16x8){vlo[i][0],vlo[i][1],vlo[i][2],vlo[i][3],vhi[i][0],vhi[i][1],vhi[i][2],vhi[i][3]}
  #define PIN(x) asm volatile("":"+v"(x))
  #define MX3(a,b,c) __builtin_fmaxf(__builtin_fmaxf((a),(b)),(c))
  #define GAPA(MF,A0,A1,A2,A3,W0,W1,PW) do{ MF; sacc+=A0; sacc+=A1; sacc+=A2; sacc+=A3; PIN(sacc); W0; W1; PIN(PW); SBAR(); }while(0)
  #define EX(v) __builtin_amdgcn_exp2f(v)
  #define GAPB(MF,X,B) do{ MF; X[B]=EX(X[B]); X[B+1]=EX(X[B+1]); X[B+2]=EX(X[B+2]); X[B+3]=EX(X[B+3]); PIN(X); SBAR(); }while(0)
  #define VRD(i) do{ vlo[i]=vtr(vp_+(((i)>>2)*4096+((i)&3)*1024)); vhi[i]=vtr(vp_+(((i)>>2)*4096+((i)&3)*1024+512)); }while(0)
  #define KRD(G,j) do{ if(G){ kload2(kf,kp0+sl_next,j); SBAR(); } }while(0)
  #define STEP(C0,C1,P0,P1,t,GK,GV,GL) do{ SBAR(); \
    const lds_cptr vp_=vp0+sl_prev; \
    VRD(0); SBAR(); float sacc=(P0[0]+P0[1]); \
    GAPA(C0=__builtin_amdgcn_mfma_f32_32x32x16_bf16(kf[0],qr[0],zero16,0,0,0), P0[2],P0[3],P0[4],P0[5],     pw0[0]=PKW(P0,0), pw0[1]=PKW(P0,2), pw0); \
    VRD(4); SBAR(); GAPA(C1=__builtin_amdgcn_mfma_f32_32x32x16_bf16(kf[1],qr[0],zero16,0,0,0), P0[6],P0[7],P0[8],P0[9],     pw0[2]=PKW(P0,4), pw0[3]=PKW(P0,6), pw0); \
    VRD(1); SBAR(); GAPA(C0=__builtin_amdgcn_mfma_f32_32x32x16_bf16(kf[2],qr[1],C0,0,0,0),   P0[10],P0[11],P0[12],P0[13], pw1[0]=PKW(P0,8), pw1[1]=PKW(P0,10), pw1); \
    VRD(5); SBAR(); GAPA(C1=__builtin_amdgcn_mfma_f32_32x32x16_bf16(kf[3],qr[1],C1,0,0,0),   P0[14],P0[15],P1[0],P1[1],   pw1[2]=PKW(P0,12),pw1[3]=PKW(P0,14), pw1); \
    VRD(2); SBAR(); GAPA(C0=__builtin_amdgcn_mfma_f32_32x32x16_bf16(kf[4],qr[2],C0,0,0,0),   P1[2],P1[3],P1[4],P1[5],     pw2[0]=PKW(P1,0), pw2[1]=PKW(P1,2), pw2); \
    VRD(6); SBAR(); GAPA(C1=__builtin_amdgcn_mfma_f32_32x32x16_bf16(kf[5],qr[2],C1,0,0,0),   P1[6],P1[7],P1[8],P1[9],     pw2[2]=PKW(P1,4), pw2[3]=PKW(P1,6), pw2); \
    VRD(3); SBAR(); GAPA(C0=__builtin_amdgcn_mfma_f32_32x32x16_bf16(kf[6],qr[3],C0,0,0,0),   P1[10],P1[11],P1[12],P1[13], pw3[0]=PKW(P1,8), pw3[1]=PKW(P1,10), pw3); \
    VRD(7); SBAR(); GAPA(C1=__builtin_amdgcn_mfma_f32_32x32x16_bf16(kf[7],qr[3],C1,0,0,0),   P1[14],P1[15],0.f,0.f,       pw3[2]=PKW(P1,12),pw3[3]=PKW(P1,14), pw3); \
    l_reg+=sacc; \
    if(GK){DMA_K((t)+3,sl_cur);} if(GV){DMA_V((t)+1,sl_next);} \
    _Pragma("unroll") for(int r=0;r<16;++r){C0[r]-=mhat;C1[r]-=mhat;} \
    CMASK(C0,C1,t); \
    { float a=MX3(C0[0],C0[1],C1[0]),b=MX3(C0[2],C0[3],C1[1]); a=MX3(a,C1[2],C1[3]); \
      _Pragma("unroll") for(int r=4;r<16;r+=4){a=MX3(a,C0[r],C0[r+1]);b=MX3(b,C0[r+2],C0[r+3]);a=MX3(a,C1[r],C1[r+1]);b=MX3(b,C1[r+2],C1[r+3]);} \
      float rm=__builtin_fmaxf(a,b); { auto rr=__builtin_amdgcn_permlane32_swap(__float_as_uint(rm),__float_as_uint(rm),false,false); rm=__builtin_fmaxf(__uint_as_float(rr[0]),__uint_as_float(rr[1])); } \
      resc=false; \
      if(__builtin_expect(__any(rm>(float)THRL),0)){ const float dl=__builtin_fmaxf(rm,0.f); mhat+=dl; \
        _Pragma("unroll") for(int r=0;r<16;++r){C0[r]-=dl;C1[r]-=dl;} \
        const float f=__builtin_amdgcn_exp2f(-dl); l_reg*=f; if(hi==0)wsf[r32]=f; resc=true; } } \
    SBAR(); \
    GAPB(o[0]=__builtin_amdgcn_mfma_f32_32x32x16_bf16(PAF(0),VFR(0),o[0],0,0,0), C0,0); \
    GAPB(o[1]=__builtin_amdgcn_mfma_f32_32x32x16_bf16(PAF(0),VFR(4),o[1],0,0,0), C0,4); \
    KRD(GL,0); GAPB(o[0]=__builtin_amdgcn_mfma_f32_32x32x16_bf16(PAF(1),VFR(1),o[0],0,0,0), C0,8); \
    KRD(GL,1); GAPB(o[1]=__builtin_amdgcn_mfma_f32_32x32x16_bf16(PAF(1),VFR(5),o[1],0,0,0), C0,12); \
    KRD(GL,2); GAPB(o[0]=__builtin_amdgcn_mfma_f32_32x32x16_bf16(PAF(2),VFR(2),o[0],0,0,0), C1,0); \
    KRD(GL,3); GAPB(o[1]=__builtin_amdgcn_mfma_f32_32x32x16_bf16(PAF(2),VFR(6),o[1],0,0,0), C1,4); \
    GAPB(o[0]=__builtin_amdgcn_mfma_f32_32x32x16_bf16(PAF(3),VFR(3),o[0],0,0,0), C1,8); \
    GAPB(o[1]=__builtin_amdgcn_mfma_f32_32x32x16_bf16(PAF(3),VFR(7),o[1],0,0,0), C1,12); \
    }while(0)
  int t=1;
  #undef CMASK
  #define CMASK(P0,P1,t) do{}while(0)
  for(;t+5<NT;t+=2){
    STEP(pB0,pB1,pA0,pA1,t,true,true,true);     WAIT_BAR(2); RESC(); ROT();
    STEP(pA0,pA1,pB0,pB1,t+1,true,true,true);   WAIT_BAR(2); RESC(); ROT();
  }
  #undef CMASK
  #define CMASK(P0,P1,t) do{int jb_=(t)-(NT-4); if(jb_>=0)cmask(P0,P1,jb_,qrel,hi);}while(0)
  #define ENDW(tt) do{ if((tt)+3<NT){WAIT_BAR(2);} else if((tt)+2<NT){WAIT_BAR(1);} else {WAIT_BAR(0);} }while(0)
  for(;t+1<NT;t+=2){
    STEP(pB0,pB1,pA0,pA1,t,(t+3<NT),(t+1<NT),(t+1<NT));       ENDW(t);   RESC(); ROT();
    STEP(pA0,pA1,pB0,pB1,t+1,(t+4<NT),(t+2<NT),(t+2<NT));     ENDW(t+1); RESC(); ROT();
  }
  STEP(pB0,pB1,pA0,pA1,NT-1,false,false,false); RESC();
  { float sacc=pB0[0]+pB0[1]; _Pragma("unroll") for(int r=2;r<16;++r)sacc+=pB0[r]; _Pragma("unroll") for(int r=0;r<16;++r)sacc+=pB1[r]; l_reg+=sacc;
    pw0=(u32x4){PKW(pB0,0),PKW(pB0,2),PKW(pB0,4),PKW(pB0,6)};pw1=(u32x4){PKW(pB0,8),PKW(pB0,10),PKW(pB0,12),PKW(pB0,14)};pw2=(u32x4){PKW(pB1,0),PKW(pB1,2),PKW(pB1,4),PKW(pB1,6)};pw3=(u32x4){PKW(pB1,8),PKW(pB1,10),PKW(pB1,12),PKW(pB1,14)};
    SBAR(); pv(o,vb0+sl_cur,PAF(0),PAF(1),PAF(2),PAF(3)); }
  #undef PKW
  #undef PAF
  #undef VFR
  #undef PIN
  #undef MX3
  #undef GAPA
  #undef GAPB
  #undef EX
  #undef VRD
  #undef KRD
  #undef STEP
  #undef ENDW
  {auto rr=__builtin_amdgcn_permlane32_swap(__float_as_uint(l_reg),__float_as_uint(l_reg),false,false);l_reg=__uint_as_float(rr[0])+__uint_as_float(rr[1]);}
  if(hi==0)wsf[32+r32]=l_reg;asm volatile("s_waitcnt lgkmcnt(0)":::"memory");
  float rli[16];
  #pragma unroll
  for(int r=0;r<16;++r)rli[r]=__builtin_amdgcn_rcpf(wsf[32+crow(r,hi)]);
  bf16*Ow=O+(rowbase+q0+wid*QBLK)*DM+oc;
  { bf16*stg=(bf16*)(shm+LDS_OST)+wid*2048;
    #pragma unroll
    for(int r=0;r<16;++r){const int orow=crow(r,hi);
      #pragma unroll
      for(int d0=0;d0<2;++d0)stg[orow*64+d0*32+r32]=__float2bfloat16(o[d0][r]*rli[r]);}
    asm volatile("s_waitcnt lgkmcnt(0)":::"memory");
    #pragma unroll
    for(int i=0;i<4;++i){const int row=i*8+(lane>>3),ch=lane&7; const u32x4 v=*(const u32x4*)(stg+row*64+ch*8); ATTN_STORE16(Ow+(long)row*DM+ch*8,v);} }
  asm volatile("s_waitcnt lgkmcnt(0)\n\ts_barrier":::"memory");
  #undef DMA_K
  #undef DMA_V
  #undef CMASK
  #undef START
  #undef RESC
  #undef ROT
}
constexpr int ATTN_LDS_BYTES=LDS_BYTES;
#undef SBAR
#undef WAIT_BAR
}
#define LAS __attribute__((address_space(3)))
#define XB_TMO      128
#define XB_XCNT(j)  (256  + 64 * (j))
#define XB_XSUB(j)  (1280 + 64 * (j))
#define XB_XGEN(j)  (2304 + 64 * (j))
#define XB_TOP      3328
#define XB_TOPGEN   3392
#define XCD_BAR_WORDS 3456
#define XB_SPIN_CAP (1u << 18)

__device__ __forceinline__ unsigned xb_ld(unsigned* p)              { return __hip_atomic_load(p, __ATOMIC_RELAXED, __HIP_MEMORY_SCOPE_AGENT); }
__device__ __forceinline__ unsigned xb_add(unsigned* p, unsigned v) { return __hip_atomic_fetch_add(p, v, __ATOMIC_RELAXED, __HIP_MEMORY_SCOPE_AGENT); }
__device__ __forceinline__ unsigned xb_xcc_id() { return (unsigned)__builtin_amdgcn_s_getreg((3 << 11) | 20) & 0xFu; }
#define XB_SPIN(cond, bar) do { unsigned _sp = 0; while (cond) { __builtin_amdgcn_s_sleep(1); \
    if ((++_sp & 255u) == 0u) { if (xb_ld(&(bar)[XB_TMO])) break; if (_sp > XB_SPIN_CAP) { atomicAdd(&(bar)[XB_TMO], 1u); break; } } } } while (0)

struct XcdBarrier {
    unsigned* bar; unsigned x;
    volatile LAS unsigned* st;
};

__device__ __forceinline__ XcdBarrier xcd_barrier_post(unsigned* bar, volatile LAS unsigned* st) {
    XcdBarrier b; b.bar = bar; b.x = xb_xcc_id(); b.st = st;
    if (fresh_tid() == 0) (void)xb_add(&bar[XB_XCNT(b.x)], 1u);
    return b;
}
__device__ __forceinline__ void xcd_barrier_complete(unsigned* bar, unsigned x, unsigned& nloc, unsigned& nx) {
    const unsigned G = gridDim.x * gridDim.y * gridDim.z;
    unsigned sum, cnt, mine, sp = 0u;
    for (;;) {
        sum = 0u; cnt = 0u; mine = 0u;
#pragma unroll
        for (unsigned j = 0; j < 16; ++j) { const unsigned c = xb_ld(&bar[XB_XCNT(j)]); sum += c; cnt += (c > 0u) ? 1u : 0u; mine = (j == x) ? c : mine; }
        if (sum == G) break;
        __builtin_amdgcn_s_sleep(1);
        if ((++sp & 255u) == 0u) { if (xb_ld(&bar[XB_TMO])) break; if (sp > XB_SPIN_CAP) { atomicAdd(&bar[XB_TMO], 1u); break; } }
    }
    nloc = mine > 0u ? mine : 1u; nx = cnt > 0u ? cnt : 1u;
}

__device__ __forceinline__ void xcd_barrier(const XcdBarrier& b) {
    asm volatile("s_waitcnt vmcnt(0)" ::: "memory");
    __syncthreads();
    if (fresh_tid() == 0) {
        unsigned* bar = b.bar;
        __builtin_amdgcn_s_waitcnt(0);
        unsigned nloc = b.st[0], nx = b.st[1];
        if (nloc == 0u) { xcd_barrier_complete(bar, b.x, nloc, nx); b.st[0] = nloc; b.st[1] = nx; }
        const unsigned old = xb_add(&bar[XB_XSUB(b.x)], 1u);
        const unsigned gen = old / nloc;
        if (old + 1u == (gen + 1u) * nloc) {
            __builtin_amdgcn_fence(__ATOMIC_RELEASE, "agent");
            asm volatile("s_waitcnt vmcnt(0)" ::: "memory");
            const unsigned og = xb_add(&bar[XB_TOP], 1u);
            const unsigned tg = og / nx;
            if (og + 1u == (tg + 1u) * nx) xb_add(&bar[XB_TOPGEN], 1u);
            else XB_SPIN(xb_ld(&bar[XB_TOPGEN]) == tg, bar);
            __builtin_amdgcn_fence(__ATOMIC_ACQUIRE, "agent");
            xb_add(&bar[XB_XGEN(b.x)], 1u);
            asm volatile("s_waitcnt vmcnt(0)" ::: "memory");
        } else {
            XB_SPIN(xb_ld(&bar[XB_XGEN(b.x)]) == gen, bar);
            __builtin_amdgcn_fence(__ATOMIC_ACQUIRE, "agent");
            asm volatile("s_waitcnt vmcnt(0)" ::: "memory");
        }
    }
    __syncthreads();
}

namespace attn_body {
struct AttnTensors { const bf16* Q; const bf16* K; const bf16* V; bf16* O; bf16* O2; };
struct AttnUnit { int bh; int qb; };
struct StaticOrder {
  int vcu, G;
  __device__ __forceinline__ explicit StaticOrder(int v,int g):vcu(v),G(g){}
  __device__ __forceinline__ bool next(int i,AttnUnit&u)const{ const int n=i*G+vcu; if(n>=4096)return false; const int cu=n&255, ii=n>>8, xcd=cu>>5, j=cu&31, s=j&7;
    u.bh=((xcd*8+(ii>>1))<<2)|(j>>3); u.qb=(ii&1)?15-s:s; return true; }
};
template<class Sched,int THRL=8> __device__ __forceinline__ void attn_phase(char*lds,const AttnTensors&T,const Sched&S){
  AttnUnit u;
  for(int i=0;S.next(i,u);++i){ const int vv=u.bh, bhh=vv>>2, c=(vv>>1)&1, vh=vv&1, b=bhh>>3, h=bhh&7; attn_unit<THRL>(b,h*128+c*64,h*128+c*64,h*128+vh*64,h*128+vh*64,u.qb,T.Q,T.K,T.V,c?T.O2:T.O,lds); }
}
}

#define DI __device__ __forceinline__
#define LAS __attribute__((address_space(3)))
typedef unsigned short bf16_t;
typedef short bf16x8 __attribute__((ext_vector_type(8)));
typedef float f32x4 __attribute__((ext_vector_type(4)));
typedef float f32x16 __attribute__((ext_vector_type(16)));
typedef unsigned u32x4 __attribute__((ext_vector_type(4)));
typedef unsigned u32x2 __attribute__((ext_vector_type(2)));

constexpr int T_TOK = 32768, DM = 1024, SEQ = 4096, NB = 8;
constexpr size_t UNIT = (size_t)64 << 20, MiB = (size_t)1 << 20;
constexpr float EPS = 1e-6f;
constexpr int NTHR = 512;
constexpr int LDS_BYTES = 147456;
constexpr size_t WS_Q = 0, WS_K = UNIT, WS_V = 2 * UNIT, WS_Z = 3 * UNIT, WS_MVT = 5 * UNIT, WS_XN = 6 * UNIT, WS_MISC = 7 * UNIT;
constexpr size_t WS_Y0 = 0;
constexpr size_t WS_U = 0, WS_SZ = 2 * UNIT, WS_VT1 = 4 * UNIT, WS_Y1 = 2 * UNIT;
constexpr size_t MS_WT1 = WS_MISC, MS_WO0 = WS_MISC + 16 * MiB, MS_WUZ = WS_MISC + 20 * MiB, MS_WV = WS_MISC + 28 * MiB, MS_WO1 = WS_MISC + 32 * MiB;
constexpr size_t MS_GI = WS_MISC + 36 * MiB, MS_GF = MS_GI + 512 * 1024;
constexpr size_t MS_BCUM = WS_MISC + 37 * MiB, MS_A = MS_BCUM + 512 * 1024, MS_PM = MS_A + 512 * 1024, MS_WGT = MS_PM + 512 * 1024;
constexpr size_t MS_MPREV = WS_MISC + 39 * MiB, MS_DECAY = MS_MPREV + 4096, MS_DN = WS_MISC + 39 * MiB + 512 * 1024;
constexpr size_t MS_RSQ = WS_MISC + 40 * MiB, MS_CSQ = WS_MISC + 42 * MiB;
constexpr size_t MS_BAR = WS_MISC + 44 * MiB;
constexpr size_t WS_NEED = 8 * UNIT;

struct Params { const float* in[22]; float* out; unsigned char* ws; };

DI unsigned f2bf(float f) { unsigned u = __builtin_bit_cast(unsigned, f); return (u + 0x7fffu + ((u >> 16) & 1u)) >> 16; }
DI unsigned pk2(float lo, float hi) { return pg8::cvt_pk_bf16(lo, hi); }
DI float bflo(unsigned w) { return __builtin_bit_cast(float, w << 16); }
DI float bfhi(unsigned w) { return __builtin_bit_cast(float, w & 0xffff0000u); }
DI float bf2f(bf16_t h) { return __builtin_bit_cast(float, (unsigned)h << 16); }
DI void unpack8(const u32x4 w, float (&f)[8]) { f[0] = bflo(w.x); f[1] = bfhi(w.x); f[2] = bflo(w.y); f[3] = bfhi(w.y); f[4] = bflo(w.z); f[5] = bfhi(w.z); f[6] = bflo(w.w); f[7] = bfhi(w.w); }
DI u32x4 pack8(const float (&f)[8]) { u32x4 w; w.x = pk2(f[0], f[1]); w.y = pk2(f[2], f[3]); w.z = pk2(f[4], f[5]); w.w = pk2(f[6], f[7]); return w; }
DI float wave_sum(float v) {
#pragma unroll
    for (int o = 1; o < 64; o <<= 1) v += __shfl_xor(v, o);
    return v;
}
DI float silu_f(float x) { return x * __builtin_amdgcn_rcpf(1.0f + __builtin_amdgcn_exp2f(x * -1.4426950408889634f)); }
DI float sigmoid_f(float x) { return __builtin_amdgcn_rcpf(1.0f + __builtin_amdgcn_exp2f(x * -1.4426950408889634f)); }
DI int crow(int r, int hi) { return (r & 3) + 8 * (r >> 2) + 4 * hi; }
#define MFMA32(a, b, c) __builtin_amdgcn_mfma_f32_32x32x16_bf16((a), (b), (c), 0, 0, 0)
#define LDS_WAIT() asm volatile("s_waitcnt lgkmcnt(0)" ::: "memory")

DI void tr_item(const float* W, int ldw, int col0, int ncols, int K, bf16_t* WT, LAS float* scr, int item, int lane) {
    const int nblk = ncols / 32, kb = item / nblk, nb = item % nblk, k0 = 64 * kb, n0 = 32 * nb;
#pragma unroll 8
    for (int i = 0; i < 32; ++i) { const int kk = 2 * i + (lane >> 5); scr[kk * 33 + (lane & 31)] = W[(size_t)(k0 + kk) * ldw + col0 + n0 + (lane & 31)]; }
    LDS_WAIT(); asm volatile("" ::: "memory");
    const int c = lane & 7;
#pragma unroll
    for (int j = 0; j < 4; ++j) { const int n = (lane >> 3) + 8 * j; const LAS float* s = scr + (8 * c) * 33 + n;
        u32x4 o; o.x = pk2(s[0 * 33], s[1 * 33]); o.y = pk2(s[2 * 33], s[3 * 33]); o.z = pk2(s[4 * 33], s[5 * 33]); o.w = pk2(s[6 * 33], s[7 * 33]);
        *(u32x4*)(WT + (size_t)(n0 + n) * K + k0 + 8 * c) = o; }
    LDS_WAIT(); asm volatile("" ::: "memory");
}
DI void p0_prologue(const Params& P, LAS unsigned char* lds, int vcu, int G) {
    const int tid = fresh_tid(), lane = tid & 63, wave = tid >> 6;
    LAS float* scr = (LAS float*)(lds + wave * 16384);
    const int gw = vcu * 8 + wave, NGW = G * 8;
    unsigned char* ws = P.ws;
    constexpr int I_SEG = 16 * 32, I_O = 32 * 32, I_L1 = 16 * 64;
    constexpr int NITEMS = 8 * I_SEG + I_O + 3 * I_L1 + I_O;
    for (int it = gw; it < NITEMS; it += NGW) {
        int r = it;
        if (r < 8 * I_SEG) { const int seg = r / I_SEG; r -= seg * I_SEG;
            const int col0 = seg < 5 ? seg * 1024 : (seg == 5 ? 6152 : (seg == 6 ? 7176 : 5120));
            tr_item(P.in[2], 8200, col0, 1024, 1024, (bf16_t*)(ws + MS_WT1) + (size_t)seg * 1024 * 1024, scr, r, lane); continue; }
        r -= 8 * I_SEG;
        if (r < I_O) { tr_item(P.in[13], 1024, 0, 1024, 2048, (bf16_t*)(ws + MS_WO0), scr, r, lane); continue; }
        r -= I_O;
        if (r < I_L1) { tr_item(P.in[16], 6144, 0, 2048, 1024, (bf16_t*)(ws + MS_WUZ), scr, r, lane); continue; }
        r -= I_L1;
        if (r < I_L1) { tr_item(P.in[16], 6144, 4096, 2048, 1024, (bf16_t*)(ws + MS_WUZ) + (size_t)2048 * 1024, scr, r, lane); continue; }
        r -= I_L1;
        if (r < I_L1) { tr_item(P.in[16], 6144, 2048, 2048, 1024, (bf16_t*)(ws + MS_WV), scr, r, lane); continue; }
        r -= I_L1;
        tr_item(P.in[20], 1024, 0, 1024, 2048, (bf16_t*)(ws + MS_WO1), scr, r, lane);
    }
    const float* x = P.in[0]; const float* pre_g = P.in[1]; const float* w_in = P.in[2];
    f32x4 g4[4], wg[4][4][2];
#pragma unroll
    for (int j = 0; j < 4; ++j) { g4[j] = *(const f32x4*)(pre_g + 4 * lane + 256 * j);
#pragma unroll
        for (int e = 0; e < 4; ++e) { const float* p = w_in + (size_t)(4 * lane + 256 * j + e) * 8200 + 6144; wg[j][e][0] = *(const f32x4*)p; wg[j][e][1] = *(const f32x4*)(p + 4); } }
    const f32x4 bi = *(const f32x4*)P.in[3], bff = *(const f32x4*)P.in[4];
    bf16_t* XN = (bf16_t*)(ws + WS_XN); float* gi = (float*)(ws + MS_GI); float* gf = (float*)(ws + MS_GF);
    for (int m = gw; m < T_TOK; m += NGW) {
        const f32x4* xr = (const f32x4*)(x + (size_t)m * DM) + lane;
        f32x4 v[4]; float ss = 0.f;
#pragma unroll
        for (int j = 0; j < 4; ++j) { v[j] = xr[64 * j]; ss += (v[j].x * v[j].x + v[j].y * v[j].y) + (v[j].z * v[j].z + v[j].w * v[j].w); }
        const float rstd = 1.0f / sqrtf(wave_sum(ss) * (1.f / DM) + EPS);
        unsigned long long* o8 = (unsigned long long*)(XN + (size_t)m * DM) + lane;
        f32x4 p0 = (f32x4){0.f, 0.f, 0.f, 0.f}, p1 = p0;
#pragma unroll
        for (int j = 0; j < 4; ++j) { const f32x4 xn = v[j] * rstd * g4[j];
            o8[64 * j] = (unsigned long long)pk2(xn.x, xn.y) | ((unsigned long long)pk2(xn.z, xn.w) << 32);
#pragma unroll
            for (int e = 0; e < 4; ++e) { p0 += xn[e] * wg[j][e][0]; p1 += xn[e] * wg[j][e][1]; } }
#pragma unroll
        for (int e = 0; e < 4; ++e) { p0[e] = wave_sum(p0[e]); p1[e] = wave_sum(p1[e]); }
        if (lane == 0) { *(f32x4*)(gi + (size_t)m * 4) = p0 + bi; *(f32x4*)(gf + (size_t)m * 4) = p1 + bff; }
    }
}

DI void gate_scan(const Params& P, LAS unsigned char* lds, int bh) {
    const int tid = fresh_tid(), l15 = tid & 15, ch = tid >> 4; const int b = bh >> 2, h = bh & 3;
    LAS float* cbl = (LAS float*)lds; LAS float* cgm = cbl + 32; LAS float* cmp = cgm + 32; LAS float* cmn = cmp + 32;
    unsigned char* ws = P.ws;
    const float* gi = (const float*)(ws + MS_GI); const float* gf = (const float*)(ws + MS_GF);
    float cs[8], aa[8], pmx[8]; float run = 0.f;
#pragma unroll
    for (int j = 0; j < 8; ++j) { const size_t row = (size_t)b * SEQ + 8 * tid + j; const float f = gf[row * 4 + h];
        run += fminf(f, 0.f) - log1pf(expf(-fabsf(f))); cs[j] = run; aa[j] = gi[row * 4 + h]; }
    float incl = run;
#pragma unroll
    for (int d = 1; d < 16; d <<= 1) { const float v = __shfl_up(incl, d, 16); if (l15 >= d) incl += v; }
    const float excl = incl - run; const float bl = __shfl(incl, 15, 16);
    float amax = -INFINITY;
#pragma unroll
    for (int j = 0; j < 8; ++j) { cs[j] += excl; aa[j] -= cs[j]; amax = fmaxf(amax, aa[j]); pmx[j] = amax; }
    float pin = amax;
#pragma unroll
    for (int d = 1; d < 16; d <<= 1) { const float v = __shfl_up(pin, d, 16); if (l15 >= d) pin = fmaxf(pin, v); }
    float pex = __shfl_up(pin, 1, 16); if (l15 == 0) pex = -INFINITY;
    const float gmax = __shfl(pin, 15, 16);
    if (l15 == 0) { cbl[ch] = bl; cgm[ch] = bl + gmax; }
    __syncthreads();
    if (tid == 0) { float m = 0.f; float* mp = (float*)(ws + MS_MPREV) + bh * 32; float* dc = (float*)(ws + MS_DECAY) + bh * 32;
        for (int c = 0; c < 32; ++c) { cmp[c] = m; const float mn = fmaxf(cbl[c] + m, cgm[c]); const float de = expf(cbl[c] + m - mn); cmn[c] = mn; mp[c] = m; dc[c] = de; m = mn; } }
    __syncthreads();
    const float mprev = cmp[ch], mnew = cmn[ch];
    float pm[8], wv[8];
#pragma unroll
    for (int j = 0; j < 8; ++j) { pm[j] = fmaxf(fmaxf(mprev, pex), pmx[j]); wv[j] = expf(bl + aa[j] - mnew); }
    const size_t o = (size_t)bh * SEQ + 8 * tid;
    float* o_bc = (float*)(ws + MS_BCUM) + o; float* o_a = (float*)(ws + MS_A) + o; float* o_pm = (float*)(ws + MS_PM) + o; float* o_w = (float*)(ws + MS_WGT) + o;
    *(f32x4*)o_bc = (f32x4){cs[0], cs[1], cs[2], cs[3]}; *(f32x4*)(o_bc + 4) = (f32x4){cs[4], cs[5], cs[6], cs[7]};
    *(f32x4*)o_a = (f32x4){aa[0], aa[1], aa[2], aa[3]}; *(f32x4*)(o_a + 4) = (f32x4){aa[4], aa[5], aa[6], aa[7]};
    *(f32x4*)o_pm = (f32x4){pm[0], pm[1], pm[2], pm[3]}; *(f32x4*)(o_pm + 4) = (f32x4){pm[4], pm[5], pm[6], pm[7]};
    *(f32x4*)o_w = (f32x4){wv[0], wv[1], wv[2], wv[3]}; *(f32x4*)(o_w + 4) = (f32x4){wv[4], wv[5], wv[6], wv[7]};
    __syncthreads();
}

DI void conv8(const bf16_t* src, const float* cw, const float* cb, int b, int t, int ch, float (&o)[8]) {
    const f32x4 b0 = *(const f32x4*)(cb + ch), b1 = *(const f32x4*)(cb + ch + 4);
    float acc[8] = {b0.x, b0.y, b0.z, b0.w, b1.x, b1.y, b1.z, b1.w};
#pragma unroll
    for (int j = 0; j < 4; ++j) { const int tt = t - 3 + j;
        if (tt >= 0) { const u32x4 xw = *(const u32x4*)(src + ((size_t)b * SEQ + tt) * 1024 + ch); float xf[8]; unpack8(xw, xf);
            const f32x4 w0 = *(const f32x4*)(cw + j * 1024 + ch), w1 = *(const f32x4*)(cw + j * 1024 + ch + 4);
            acc[0] += w0.x * xf[0]; acc[1] += w0.y * xf[1]; acc[2] += w0.z * xf[2]; acc[3] += w0.w * xf[3];
            acc[4] += w1.x * xf[4]; acc[5] += w1.y * xf[5]; acc[6] += w1.z * xf[6]; acc[7] += w1.w * xf[7]; } }
#pragma unroll
    for (int e = 0; e < 8; ++e) o[e] = silu_f(acc[e]);
}

constexpr int KP = 136;
DI void mlstm_i_unit(const Params& P, LAS unsigned char* lds, int bh, int c) {
    const int tid = fresh_tid(), lane = tid & 63, w = tid >> 6, l32 = lane & 31, hi = lane >> 5;
    const int b = bh >> 2, h = bh & 3; const size_t tok0 = (size_t)b * SEQ + c * 128;
    unsigned char* ws = P.ws;
    const bf16_t* MQK = (const bf16_t*)P.out; const bf16_t* MVT = (const bf16_t*)(ws + WS_MVT);
    const float* wgt = (const float*)(ws + MS_WGT) + (size_t)bh * SEQ + c * 128;
    LAS bf16_t* KT = (LAS bf16_t*)lds;
    bf16x8 av[8]; { const bf16_t* vp = MVT + (size_t)(h * 256 + 32 * w + l32) * T_TOK + tok0 + 8 * hi;
#pragma unroll
        for (int ks = 0; ks < 8; ++ks) av[ks] = *(const bf16x8*)(vp + 16 * ks); }
    for (int i = 0; i < 4; ++i) { const int task = i * NTHR + tid, d8 = task & 15, s = task >> 4; float o[8];
        conv8(MQK, P.in[5], P.in[6], b, c * 128 + s, 512 + h * 128 + d8 * 8, o); const float wv = wgt[s];
#pragma unroll
        for (int e = 0; e < 8; ++e) KT[(d8 * 8 + e) * KP + s] = (bf16_t)f2bf(o[e] * wv); }
    __syncthreads();
    f32x16 acc[4];
#pragma unroll
    for (int db = 0; db < 4; ++db) { acc[db] = (f32x16){};
#pragma unroll
        for (int ks = 0; ks < 8; ++ks) { const bf16x8 bf = *(const LAS bf16x8*)(KT + (32 * db + l32) * KP + 16 * ks + 8 * hi); acc[db] = MFMA32(av[ks], bf, acc[db]); } }
    bf16_t* dst = (bf16_t*)(ws + WS_XN) + ((size_t)(bh * 32 + c) * 256) * 128;
#pragma unroll
    for (int db = 0; db < 4; ++db)
#pragma unroll
        for (int r = 0; r < 16; ++r) dst[(size_t)(32 * w + crow(r, hi)) * 128 + 32 * db + l32] = (bf16_t)f2bf(acc[db][r]);
    { const int d = tid >> 2, q = tid & 3; float s = 0.f;
        for (int j = 0; j < 32; ++j) s += bf2f(KT[d * KP + 32 * q + j]);
        s += __shfl_xor(s, 1); s += __shfl_xor(s, 2);
        if (q == 0) ((float*)(ws + MS_DN))[(size_t)(bh * 32 + c) * 128 + d] = s; }
    __syncthreads();
}

DI void mlstm_scan(const Params& P, int vcu, int G) {
    unsigned char* ws = P.ws; const float* decay = (const float*)(ws + MS_DECAY);
    for (int gid = vcu * NTHR + fresh_tid(); gid < 32 * 4096; gid += G * NTHR) {
        const int bh = gid >> 12, e8 = gid & 4095;
        bf16_t* p = (bf16_t*)(ws + WS_XN) + (size_t)bh * 32 * 32768 + (size_t)e8 * 8;
        float st[8] = {0.f, 0.f, 0.f, 0.f, 0.f, 0.f, 0.f, 0.f};
#pragma unroll 4
        for (int c = 0; c < 32; ++c) { const u32x4 v = *(const u32x4*)(p + (size_t)c * 32768); float f[8]; unpack8(v, f); const float de = decay[bh * 32 + c];
            *(u32x4*)(p + (size_t)c * 32768) = pack8(st);
#pragma unroll
            for (int e = 0; e < 8; ++e) st[e] = de * st[e] + f[e]; }
    }
    for (int gid = vcu * NTHR + fresh_tid(); gid < 32 * 128; gid += G * NTHR) {
        const int bh = gid >> 7, d = gid & 127; float* p = (float*)(ws + MS_DN) + (size_t)bh * 32 * 128 + d; float st = 0.f;
        for (int c = 0; c < 32; ++c) { const float v = p[c * 128]; p[c * 128] = st; st = decay[bh * 32 + c] * st + v; }
    }
}

constexpr int SP_F = 260;
DI void mlstm_out_unit(const Params& P, LAS unsigned char* lds, int bh, int c) {
    const int tid = fresh_tid(), lane = tid & 63, w = tid >> 6, l32 = lane & 31, hi = lane >> 5;
    const int b = bh >> 2, h = bh & 3; const size_t tok0 = (size_t)b * SEQ + c * 128;
    unsigned char* ws = P.ws;
    const bf16_t* MQK = (const bf16_t*)P.out; const bf16_t* MO = (const bf16_t*)((unsigned char*)P.out + UNIT);
    const bf16_t* MVT = (const bf16_t*)(ws + WS_MVT); bf16_t* Z = (bf16_t*)(ws + WS_Z);
    const bf16_t* CP = (const bf16_t*)(ws + WS_XN) + ((size_t)(bh * 32 + c) * 256) * 128;
    LAS bf16_t* QS = (LAS bf16_t*)lds; LAS bf16_t* KS = QS + 128 * KP; LAS bf16_t* SPm = KS + 128 * KP;
    LAS float* stage = (LAS float*)lds;
    LAS float* sm = (LAS float*)(lds + 133120);
    LAS float* s_a = sm; LAS float* s_pm = sm + 128; LAS float* s_bc = sm + 256; LAS float* s_n = sm + 384; LAS float* s_iw = sm + 512; LAS float* s_rd = sm + 640;
    const float mprev = ((const float*)(ws + MS_MPREV))[bh * 32 + c];
    bf16x8 cT[8], vT[8];
    { const bf16_t* cp = CP + (size_t)(32 * w + l32) * 128 + 8 * hi; const bf16_t* vp = MVT + (size_t)(h * 256 + 32 * w + l32) * T_TOK + tok0 + 8 * hi;
#pragma unroll
        for (int ks = 0; ks < 8; ++ks) { cT[ks] = *(const bf16x8*)(cp + 16 * ks); vT[ks] = *(const bf16x8*)(vp + 16 * ks); } }
    if (tid < 128) { const size_t o = (size_t)bh * SEQ + c * 128 + tid; s_a[tid] = ((const float*)(ws + MS_A))[o]; s_pm[tid] = ((const float*)(ws + MS_PM))[o]; s_bc[tid] = ((const float*)(ws + MS_BCUM))[o];
        s_n[tid] = ((const float*)(ws + MS_DN))[(size_t)(bh * 32 + c) * 128 + tid]; }
    for (int i = 0; i < 8; ++i) { const int task = i * NTHR + tid, g = task & 31, t = task >> 5; const bool isk = g >= 16; const int d8 = g & 15; float o[8];
        conv8(MQK, P.in[5], P.in[6], b, c * 128 + t, (isk ? 512 : 0) + h * 128 + d8 * 8, o);
        if (!isk) {
#pragma unroll
            for (int e = 0; e < 8; ++e) o[e] *= 0.08838834764831845f; }
        *(LAS u32x4*)((isk ? KS : QS) + t * KP + d8 * 8) = pack8(o); }
    __syncthreads();
    { const int tb = w & 3, sb0 = (w >> 2) * 2;
#pragma unroll
        for (int j = 0; j < 2; ++j) { const int sb = sb0 + j; f32x16 acc = (f32x16){};
            if (sb <= tb) {
#pragma unroll
                for (int ks = 0; ks < 8; ++ks) { const bf16x8 a = *(const LAS bf16x8*)(QS + (32 * tb + l32) * KP + 16 * ks + 8 * hi); const bf16x8 bb = *(const LAS bf16x8*)(KS + (32 * sb + l32) * KP + 16 * ks + 8 * hi); acc = MFMA32(a, bb, acc); } }
            const int s = 32 * sb + l32; const float as = s_a[s];
#pragma unroll
            for (int r = 0; r < 16; ++r) { const int t = 32 * tb + crow(r, hi); const float v = (s <= t) ? acc[r] * __expf(as - s_pm[t]) : 0.f; SPm[t * KP + s] = (bf16_t)f2bf(v); } } }
    __syncthreads();
    { const int t = tid >> 2, q = tid & 3; float s1 = 0.f, s2 = 0.f;
        for (int j = 0; j < 32; ++j) { s1 += bf2f(SPm[t * KP + 32 * q + j]); s2 += bf2f(QS[t * KP + 32 * q + j]) * s_n[32 * q + j]; }
        s1 += __shfl_xor(s1, 1); s1 += __shfl_xor(s1, 2); s2 += __shfl_xor(s2, 1); s2 += __shfl_xor(s2, 2);
        if (q == 0) { const float iw = __expf(mprev - s_pm[t]); const float den = s1 + iw * s2; const float lim = __expf(-(s_bc[t] + s_pm[t])); s_iw[t] = iw; s_rd[t] = 1.0f / fmaxf(fabsf(den), lim); } }
    __syncthreads();
    f32x16 acc[4];
#pragma unroll
    for (int tb = 0; tb < 4; ++tb) { acc[tb] = (f32x16){};
#pragma unroll
        for (int ks = 0; ks < 8; ++ks) { const bf16x8 a = *(const LAS bf16x8*)(QS + (32 * tb + l32) * KP + 16 * ks + 8 * hi); acc[tb] = MFMA32(a, cT[ks], acc[tb]); }
#pragma unroll
        for (int r = 0; r < 16; ++r) acc[tb][r] *= s_iw[32 * tb + crow(r, hi)];
#pragma unroll
        for (int ks = 0; ks < 8; ++ks) { if (ks < 2 * (tb + 1)) { const bf16x8 a = *(const LAS bf16x8*)(SPm + (32 * tb + l32) * KP + 16 * ks + 8 * hi); acc[tb] = MFMA32(a, vT[ks], acc[tb]); } }
#pragma unroll
        for (int r = 0; r < 16; ++r) acc[tb][r] *= s_rd[32 * tb + crow(r, hi)];
    }
    __syncthreads();
#pragma unroll
    for (int tb = 0; tb < 4; ++tb)
#pragma unroll
        for (int r = 0; r < 16; ++r) stage[(32 * tb + crow(r, hi)) * SP_F + 32 * w + l32] = acc[tb][r];
    __syncthreads();
    const float* hg = P.in[12];
    for (int i = 0; i < 8; ++i) { const int task = i * NTHR + tid, v8 = task & 31, t = task >> 5;
        const f32x4 h0 = *(const LAS f32x4*)(stage + t * SP_F + v8 * 8), h1 = *(const LAS f32x4*)(stage + t * SP_F + v8 * 8 + 4);
        float hv[8] = {h0.x, h0.y, h0.z, h0.w, h1.x, h1.y, h1.z, h1.w};
        const u32x4 ow = *(const u32x4*)(MO + (tok0 + t) * 1024 + h * 256 + v8 * 8); float of[8]; unpack8(ow, of);
        bf16_t* zp = Z + (tok0 + t) * 2048 + 1024 + h * 256 + v8 * 8; const u32x4 zw = *(const u32x4*)zp; float zf[8]; unpack8(zw, zf);
        float ss = 0.f;
#pragma unroll
        for (int e = 0; e < 8; ++e) { hv[e] *= sigmoid_f(of[e]); ss += hv[e] * hv[e]; }
        ss += __shfl_xor(ss, 1); ss += __shfl_xor(ss, 2); ss += __shfl_xor(ss, 4); ss += __shfl_xor(ss, 8); ss += __shfl_xor(ss, 16);
        const float rstd = 1.0f / sqrtf(ss * (1.f / 256.f) + EPS);
        const f32x4 g0 = *(const f32x4*)(hg + v8 * 8), g1 = *(const f32x4*)(hg + v8 * 8 + 4); const float gg[8] = {g0.x, g0.y, g0.z, g0.w, g1.x, g1.y, g1.z, g1.w};
        float y[8];
#pragma unroll
        for (int e = 0; e < 8; ++e) y[e] = hv[e] * rstd * gg[e] * silu_f(zf[e]);
        *(u32x4*)zp = pack8(y); }
    __syncthreads();
}

DI void da_combine(const Params& P, LAS unsigned char* lds, int vcu, int G) {
    const int tid = fresh_tid(), lane = tid & 63, wave = tid >> 6;
    LAS float* sl = (LAS float*)lds;
    if (wave == 0) { const float a = P.in[7][lane] * P.in[8][lane], bq = P.in[9][lane] * P.in[10][lane]; const float d1 = wave_sum(a), d2 = wave_sum(bq); if (lane == 0) sl[0] = expf(d1) - expf(d2) + 0.2f; }
    __syncthreads();
    const float lam = sl[0];
    unsigned char* ws = P.ws;
    const bf16_t* O1 = (const bf16_t*)P.out; const bf16_t* O2 = (const bf16_t*)((unsigned char*)P.out + UNIT); bf16_t* Z = (bf16_t*)(ws + WS_Z);
    float gg[16]; { const float* g = P.in[11] + (16 * lane & 127);
#pragma unroll
        for (int e = 0; e < 16; e += 4) { const f32x4 t = *(const f32x4*)(g + e); gg[e] = t.x * 0.8f; gg[e + 1] = t.y * 0.8f; gg[e + 2] = t.z * 0.8f; gg[e + 3] = t.w * 0.8f; } }
    const int gw = vcu * 8 + wave, NGW = G * 8;
    for (int m = gw; m < T_TOK; m += NGW) {
        const size_t o = (size_t)m * 1024 + 16 * lane; bf16_t* zp = Z + (size_t)m * 2048 + 16 * lane;
        float a[16], bq[16], z[16];
        { float t[8]; unpack8(*(const u32x4*)(O1 + o), t); for (int e = 0; e < 8; ++e) a[e] = t[e]; unpack8(*(const u32x4*)(O1 + o + 8), t); for (int e = 0; e < 8; ++e) a[8 + e] = t[e];
          unpack8(*(const u32x4*)(O2 + o), t); for (int e = 0; e < 8; ++e) bq[e] = t[e]; unpack8(*(const u32x4*)(O2 + o + 8), t); for (int e = 0; e < 8; ++e) bq[8 + e] = t[e];
          unpack8(*(const u32x4*)zp, t); for (int e = 0; e < 8; ++e) z[e] = t[e]; unpack8(*(const u32x4*)(zp + 8), t); for (int e = 0; e < 8; ++e) z[8 + e] = t[e]; }
        float ss = 0.f;
#pragma unroll
        for (int e = 0; e < 16; ++e) { a[e] -= lam * bq[e]; ss += a[e] * a[e]; }
        ss += __shfl_xor(ss, 1); ss += __shfl_xor(ss, 2); ss += __shfl_xor(ss, 4);
        const float rstd = 1.0f / sqrtf(ss * (1.f / 128.f) + EPS);
        float y0[8], y1[8];
#pragma unroll
        for (int e = 0; e < 8; ++e) { y0[e] = a[e] * rstd * gg[e] * silu_f(z[e]); y1[e] = a[8 + e] * rstd * gg[8 + e] * silu_f(z[8 + e]); }
        *(u32x4*)zp = pack8(y0); *(u32x4*)(zp + 8) = pack8(y1);
    }
}

template <bool XNOUT> DI void resid_rows(const float* base, const bf16_t* Y, const float* rsq, const float* post_g, const float* pre_g, float* outf, bf16_t* XN, int vcu, int G) {
    const int tid = fresh_tid(), lane = tid & 63, wave = tid >> 6;
    float pg[16], ng[16];
#pragma unroll
    for (int hf = 0; hf < 2; ++hf)
#pragma unroll
        for (int q = 0; q < 2; ++q) { const int col = hf * 512 + 8 * lane + 4 * q; const f32x4 t = *(const f32x4*)(post_g + col); pg[hf * 8 + q * 4] = t.x; pg[hf * 8 + q * 4 + 1] = t.y; pg[hf * 8 + q * 4 + 2] = t.z; pg[hf * 8 + q * 4 + 3] = t.w;
            if (XNOUT) { const f32x4 u = *(const f32x4*)(pre_g + col); ng[hf * 8 + q * 4] = u.x; ng[hf * 8 + q * 4 + 1] = u.y; ng[hf * 8 + q * 4 + 2] = u.z; ng[hf * 8 + q * 4 + 3] = u.w; } }
    const int gw = vcu * 8 + wave, NGW = G * 8;
    for (int m = gw; m < T_TOK; m += NGW) {
        float sq = rsq[(size_t)(lane & 15) * T_TOK + m]; sq += __shfl_xor(sq, 1); sq += __shfl_xor(sq, 2); sq += __shfl_xor(sq, 4); sq += __shfl_xor(sq, 8);
        const float rstd = 1.0f / sqrtf(sq * (1.f / 1024.f) + EPS);
        float hv[16]; float ss = 0.f;
#pragma unroll
        for (int hf = 0; hf < 2; ++hf) { const size_t o = (size_t)m * 1024 + hf * 512 + 8 * lane; float yf[8]; unpack8(*(const u32x4*)(Y + o), yf);
            const f32x4 b0 = *(const f32x4*)(base + o), b1 = *(const f32x4*)(base + o + 4); const float bb[8] = {b0.x, b0.y, b0.z, b0.w, b1.x, b1.y, b1.z, b1.w};
#pragma unroll
            for (int e = 0; e < 8; ++e) { const float v = bb[e] + yf[e] * rstd * pg[hf * 8 + e]; hv[hf * 8 + e] = v; ss += v * v; }
            *(f32x4*)(outf + o) = (f32x4){hv[hf * 8], hv[hf * 8 + 1], hv[hf * 8 + 2], hv[hf * 8 + 3]}; *(f32x4*)(outf + o + 4) = (f32x4){hv[hf * 8 + 4], hv[hf * 8 + 5], hv[hf * 8 + 6], hv[hf * 8 + 7]}; }
        if (XNOUT) { const float r2 = 1.0f / sqrtf(wave_sum(ss) * (1.f / 1024.f) + EPS);
#pragma unroll
            for (int hf = 0; hf < 2; ++hf) { float xo[8];
#pragma unroll
                for (int e = 0; e < 8; ++e) xo[e] = hv[hf * 8 + e] * r2 * ng[hf * 8 + e];
                *(u32x4*)(XN + (size_t)m * 1024 + hf * 512 + 8 * lane) = pack8(xo); } }
    }
}

DI void spatial_unit(const Params& P, LAS unsigned char* lds, int bc, int g) {
    const int tid = fresh_tid(), lane = tid & 63, w = tid >> 6, l32 = lane & 31, hi = lane >> 5;
    const size_t tok0 = (size_t)bc * 128;
    unsigned char* ws = P.ws;
    const bf16_t* VT = (const bf16_t*)(ws + WS_VT1); bf16_t* U = (bf16_t*)(ws + WS_U); const bf16_t* SZ = (const bf16_t*)(ws + WS_SZ);
    const float* csq = (const float*)(ws + MS_CSQ);
    LAS bf16_t* AW = (LAS bf16_t*)lds; LAS float* stage = (LAS float*)lds; LAS float* rs = (LAS float*)(lds + 133120);
    bf16x8 bv[8]; { const bf16_t* vp = VT + (size_t)(g * 256 + 32 * w + l32) * T_TOK + tok0 + 8 * hi;
#pragma unroll
        for (int ks = 0; ks < 8; ++ks) bv[ks] = *(const bf16x8*)(vp + 16 * ks); }
    if (tid < 128) { float s = 0.f; for (int p = 0; p < 16; ++p) s += csq[(size_t)p * T_TOK + tok0 + tid]; rs[tid] = 1.0f / sqrtf(s * (1.f / 2048.f) + EPS); }
    __syncthreads();
    const float* wsp = P.in[18] + (size_t)g * 128 * 128;
    for (int i = 0; i < 8; ++i) { const int task = i * NTHR + tid, s4 = task & 31, t = task >> 5; const f32x4 wv = *(const f32x4*)(wsp + t * 128 + s4 * 4); float o[4];
#pragma unroll
        for (int e = 0; e < 4; ++e) { const int s = s4 * 4 + e; o[e] = (s <= t) ? wv[e] * rs[s] : 0.f; }
        u32x2 pk; pk.x = pk2(o[0], o[1]); pk.y = pk2(o[2], o[3]); *(LAS u32x2*)(AW + t * KP + s4 * 4) = pk; }
    __syncthreads();
    f32x16 acc[4];
    const float gn = P.in[17][g * 256 + 32 * w + l32];
#pragma unroll
    for (int tb = 0; tb < 4; ++tb) { acc[tb] = (f32x16){};
#pragma unroll
        for (int ks = 0; ks < 8; ++ks) { if (ks < 2 * (tb + 1)) { const bf16x8 a = *(const LAS bf16x8*)(AW + (32 * tb + l32) * KP + 16 * ks + 8 * hi); acc[tb] = MFMA32(a, bv[ks], acc[tb]); } } }
    __syncthreads();
    const float* bsp = P.in[19] + g * 128;
#pragma unroll
    for (int tb = 0; tb < 4; ++tb)
#pragma unroll
        for (int r = 0; r < 16; ++r) { const int t = 32 * tb + crow(r, hi); stage[t * SP_F + 32 * w + l32] = acc[tb][r] * gn + bsp[t]; }
    __syncthreads();
    for (int i = 0; i < 8; ++i) { const int task = i * NTHR + tid, d8 = task & 31, t = task >> 5;
        const f32x4 h0 = *(const LAS f32x4*)(stage + t * SP_F + d8 * 8), h1 = *(const LAS f32x4*)(stage + t * SP_F + d8 * 8 + 4); const float vs[8] = {h0.x, h0.y, h0.z, h0.w, h1.x, h1.y, h1.z, h1.w};
        const size_t o = (tok0 + t) * 2048 + g * 256 + d8 * 8; float uf[8], zf[8]; unpack8(*(const u32x4*)(U + o), uf); unpack8(*(const u32x4*)(SZ + o), zf); float y[8];
#pragma unroll
        for (int e = 0; e < 8; ++e) y[e] = uf[e] * vs[e] * zf[e];
        *(u32x4*)(U + o) = pack8(y); }
    __syncthreads();
}

#ifndef PHM
#define PHM 0xFFFF
#endif
typedef const __attribute__((address_space(4))) Params* KParamsPtr;
DI KParamsPtr launder_kp(KParamsPtr p) { asm volatile("" : "+s"(p)); return p; }
DI Params load_params(KParamsPtr p) { Params r;
#pragma unroll
    for (int i = 0; i < 22; ++i) r.in[i] = p->in[i];
    r.out = p->out; r.ws = p->ws; return r; }
#define LOADP() const Params P = load_params(launder_kp(kp_)); unsigned char* const ws = P.ws; unsigned char* const ob = (unsigned char*)P.out; (void)ws; (void)ob
__global__ void __launch_bounds__(NTHR, 2) mega_fwd(Params Pk_unused) {
    KParamsPtr kp_ = (KParamsPtr)__builtin_amdgcn_kernarg_segment_ptr();
    extern __shared__ __attribute__((aligned(16))) unsigned char lds_raw[];
    LAS unsigned char* lds = (LAS unsigned char*)lds_raw;
    cg::grid_group grid = cg::this_grid();
    const int G = gridDim.x, bx = blockIdx.x;
    const int vcu = (G % 8 == 0) ? (bx % 8) * (G / 8) + bx / 8 : bx;
    typedef pg8::bf16_t pbf;
    volatile LAS unsigned* xst = (volatile LAS unsigned*)(lds + LDS_BYTES - 16);
    if (fresh_tid() == 0) { xst[0] = 0u; xst[1] = 0u; }
    __syncthreads();

    if constexpr ((PHM >> 0) & 1) { LOADP();
    if (bx == 0) { unsigned* bw = (unsigned*)(ws + MS_BAR); for (int i = fresh_tid(); i < XCD_BAR_WORDS; i += NTHR) bw[i] = 0u; }
    p0_prologue(P, lds, vcu, G);
    }
    grid.sync();
    XcdBarrier xbar; { const Params Pb = load_params(launder_kp(kp_)); xbar = xcd_barrier_post((unsigned*)(Pb.ws + MS_BAR), xst); }

    if constexpr ((PHM >> 1) & 1) { LOADP();
    for (int bh = bx; bh < 32; bh += G) gate_scan(P, lds, bh);
    { pg8::Gemm g{(const pbf*)(ws + WS_XN), (const pbf*)(ws + MS_WT1), T_TOK, 7168, 1024, 1024, 1024}; pg8::StaticOrder S; S.init(T_TOK, 7168, G, bx);
      pg8::Epi1 E{ws, ob, attn_body::C2};
      pg8::gemm_phase<pg8::Epi1, pg8::StaticOrder, true, true>(lds, g, S, E); }
    { pg8::Gemm g{(const pbf*)(ws + MS_WT1) + (size_t)7168 * 1024, (const pbf*)(ws + WS_XN), 1024, T_TOK, 1024, 1024, 1024}; pg8::StaticOrder S; S.init(1024, T_TOK, G, bx);
      pg8::EpiT<0, false> E{(pbf*)(ws + WS_MVT), T_TOK, nullptr, T_TOK};
      pg8::gemm_phase<pg8::EpiT<0, false>, pg8::StaticOrder, true, true>(lds, g, S, E); }
    }
    xcd_barrier(xbar);
    if constexpr ((PHM >> 2) & 1) { LOADP();
    for (int u = vcu; u < 1024; u += G) mlstm_i_unit(P, lds, u >> 5, u & 31);
    }
    xcd_barrier(xbar);
    if constexpr ((PHM >> 3) & 1) { LOADP();
    mlstm_scan(P, vcu, G);
    }
    xcd_barrier(xbar);
    if constexpr ((PHM >> 4) & 1) { LOADP();
    for (int u = vcu; u < 1024; u += G) mlstm_out_unit(P, lds, u >> 5, u & 31);
    }
    xcd_barrier(xbar);
    if constexpr ((PHM >> 5) & 1) { LOADP();
    { const attn_body::AttnTensors AT{(const attn_body::bf16*)(ws + WS_Q), (const attn_body::bf16*)(ws + WS_K), (const attn_body::bf16*)(ws + WS_V), (attn_body::bf16*)(ob), (attn_body::bf16*)(ob + UNIT)};
      const attn_body::StaticOrder S(vcu, G); attn_body::attn_phase<attn_body::StaticOrder>((char*)lds_raw, AT, S); }
    }
    xcd_barrier(xbar);
    if constexpr ((PHM >> 6) & 1) { LOADP();
    da_combine(P, lds, vcu, G);
    }
    xcd_barrier(xbar);
    if constexpr ((PHM >> 7) & 1) { LOADP();
    { pg8::Gemm g{(const pbf*)(ws + WS_Z), (const pbf*)(ws + MS_WO0), T_TOK, 1024, 2048, 2048, 2048}; pg8::StaticOrder S; S.init(T_TOK, 1024, G, bx);
      pg8::EpiY E{(pbf*)(ws + WS_Y0), (float*)(ws + MS_RSQ), T_TOK};
      pg8::gemm_phase<pg8::EpiY, pg8::StaticOrder, true, true>(lds, g, S, E); }
    }
    xcd_barrier(xbar);
    if constexpr ((PHM >> 8) & 1) { LOADP();
    resid_rows<true>(P.in[0], (const bf16_t*)(ws + WS_Y0), (const float*)(ws + MS_RSQ), P.in[14], P.in[15], P.out, (bf16_t*)(ws + WS_XN), vcu, G);
    }
    xcd_barrier(xbar);
    if constexpr ((PHM >> 9) & 1) { LOADP();
    { pg8::Gemm g{(const pbf*)(ws + WS_XN), (const pbf*)(ws + MS_WUZ), T_TOK, 4096, 1024, 1024, 1024}; pg8::StaticOrder S; S.init(T_TOK, 4096, G, bx);
      pg8::EpiUZ E{(pbf*)(ws + WS_U), (pbf*)(ws + WS_SZ)};
      pg8::gemm_phase<pg8::EpiUZ, pg8::StaticOrder, true, true>(lds, g, S, E); }
    { pg8::Gemm g{(const pbf*)(ws + MS_WV), (const pbf*)(ws + WS_XN), 2048, T_TOK, 1024, 1024, 1024}; pg8::StaticOrder S; S.init(2048, T_TOK, G, bx);
      pg8::EpiT<1, true> E{(pbf*)(ws + WS_VT1), T_TOK, (float*)(ws + MS_CSQ), T_TOK};
      pg8::gemm_phase<pg8::EpiT<1, true>, pg8::StaticOrder, true, true>(lds, g, S, E); }
    }
    xcd_barrier(xbar);
    if constexpr ((PHM >> 10) & 1) { LOADP();
    for (int u = vcu; u < 2048; u += G) spatial_unit(P, lds, u >> 3, u & 7);
    }
    xcd_barrier(xbar);
    if constexpr ((PHM >> 11) & 1) { LOADP();
    { pg8::Gemm g{(const pbf*)(ws + WS_U), (const pbf*)(ws + MS_WO1), T_TOK, 1024, 2048, 2048, 2048}; pg8::StaticOrder S; S.init(T_TOK, 1024, G, bx);
      pg8::EpiY E{(pbf*)(ws + WS_Y1), (float*)(ws + MS_RSQ), T_TOK};
      pg8::gemm_phase<pg8::EpiY, pg8::StaticOrder, true, true>(lds, g, S, E); }
    }
    xcd_barrier(xbar);
    if constexpr ((PHM >> 12) & 1) { LOADP();
    resid_rows<false>(P.out, (const bf16_t*)(ws + WS_Y1), (const float*)(ws + MS_RSQ), P.in[21], nullptr, P.out, nullptr, vcu, G);
    }
}

extern "C" void kernel_launch(void* const* d_in, const int* in_sizes, int n_in, void* d_out, int out_size, void* d_ws, size_t ws_size, hipStream_t stream) {
    static int grid = 0;
    if (grid == 0) {
        if (n_in != 22 || ws_size < WS_NEED || out_size != T_TOK * DM) { fprintf(stderr, "kernel_launch: unexpected shapes (n_in %d, out %d, ws %zu)\n", n_in, out_size, ws_size); grid = -1; return; }
        int dev = 0, cus = 0, per_cu = 0;
        hipGetDevice(&dev); hipDeviceGetAttribute(&cus, hipDeviceAttributeMultiprocessorCount, dev);
        hipFuncSetAttribute((const void*)mega_fwd, hipFuncAttributeMaxDynamicSharedMemorySize, LDS_BYTES);
        if (hipOccupancyMaxActiveBlocksPerMultiprocessor(&per_cu, (const void*)mega_fwd, NTHR, LDS_BYTES) != hipSuccess || per_cu < 1) per_cu = 1;
        (void)hipGetLastError();
        grid = cus * 1;
        if (grid <= 0) grid = 256;
    }
    if (grid < 0) return;
    Params p{};
    for (int i = 0; i < 22; ++i) p.in[i] = (const float*)d_in[i];
    p.out = (float*)d_out; p.ws = (unsigned char*)d_ws;
    void* args[] = {&p};
    hipError_t e = hipLaunchCooperativeKernel((const void*)mega_fwd, dim3(grid), dim3(NTHR), args, LDS_BYTES, stream);
    if (e != hipSuccess) fprintf(stderr, "cooperative launch failed: %s (grid %d)\n", hipGetErrorString(e), grid);
}
```

```cpp
#include <hip/hip_runtime.h>
#include <hip/hip_cooperative_groups.h>
#include <cstdio>
#include <cstdint>
namespace cg = cooperative_groups;
__device__ __forceinline__ int fresh_tid() { int t = (int)threadIdx.x; asm volatile("" : "+v"(t)); return t; }
#ifndef ATT_ORDER
#define ATT_ORDER 1
#endif
namespace pg8 {
#define PG8_LAS __attribute__((address_space(3)))
typedef unsigned short bf16_t;
typedef short bf16x8 __attribute__((ext_vector_type(8)));
typedef float f32x4 __attribute__((ext_vector_type(4)));
typedef unsigned u32x4 __attribute__((ext_vector_type(4)));
constexpr int BM = 256, BK = 64, HALF = 128, HTB = HALF * BK * 2  , STAGE_BYTES = 8 * HTB, NXCD = 8, WGM = 8;

__host__ __device__ __forceinline__ int lds_byte(int r, int c) { const int st = (r >> 4) * 2 + (c >> 5), rr = r & 15, cc = c & 31, ob = rr * 64 + cc * 2; return st * 1024 + (ob ^ (((ob >> 9) & 1) << 5)); }
__host__ __device__ __forceinline__ void stage_rc(int b, int& R, int& C) { const int st = b / 1024, sb = b % 1024, swz = sb ^ (((sb >> 9) & 1) << 5); R = (st >> 1) * 16 + swz / 64; C = (st & 1) * 32 + (swz % 64) / 2; }
__host__ __device__ __forceinline__ int perm32(int rho) { const int n = rho >> 4, i = rho & 15; return 8 * (i >> 2) + 4 * n + (i & 3); }

struct Unit { int pm, pn; };
struct Gemm { const bf16_t* A; const bf16_t* Bt; int M, N, K, lda, ldb; };

struct StaticOrder {
    int nM, nN, nwg, G, c;
    __host__ __device__ void init(int M, int N, int G_, int c_) { nM = M / BM; nN = N / BM; nwg = nM * nN; G = G_; c = c_; }
    __host__ __device__ bool next(int i, Unit& u) const {
        const long L = (long)i * G + c; if (L >= nwg) return false;
        int wgid = (int)L; { const int q = nwg / NXCD, r = nwg % NXCD, xcd = wgid % NXCD, off = wgid / NXCD; wgid = (xcd < r ? xcd * (q + 1) : r * (q + 1) + (xcd - r) * q) + off; }
        const int nig = WGM * nN, gid = wgid / nig, fm = gid * WGM, gsz = (nM - fm) < WGM ? (nM - fm) : WGM;
        u.pm = fm + ((wgid % nig) % gsz); u.pn = (wgid % nig) / gsz; return true;
    }
    __device__ __forceinline__ void a_ready(const Unit&) const {}
    __device__ __forceinline__ void done(const Unit&) const {}
};

__device__ __forceinline__ unsigned cvt_pk_bf16(float lo, float hi) { unsigned r; asm volatile("v_cvt_pk_bf16_f32 %0, %1, %2" : "=v"(r) : "v"(lo), "v"(hi)); return r; }
typedef float f32x2 __attribute__((ext_vector_type(2)));
__device__ __forceinline__ f32x2 gelu_pk(f32x2 v) {
    const f32x2 av = __builtin_elementwise_abs(v), d = av * 0.2316418882f + 1.0f;
    f32x2 t; t.x = __builtin_amdgcn_rcpf(d.x); t.y = __builtin_amdgcn_rcpf(d.y);
    f32x2 q = t * 0.5307027145f + (-0.7265760135f); q = q * t + 0.7107068705f; q = q * t + (-0.142248368f); q = q * t + 0.127414796f; q = q * t;
    const f32x2 s = (v * v) * (-0.72134752044f);
    f32x2 e; e.x = __builtin_amdgcn_exp2f(s.x); e.y = __builtin_amdgcn_exp2f(s.y);
    const f32x2 m = v * (q * e), r = v - m;
    f32x2 o; o.x = v.x < 0.f ? m.x : r.x; o.y = v.y < 0.f ? m.y : r.y; return o;
}

template <int ACT  > struct EpiBf16 {
    static constexpr bool PERM = true, AFTER_DRAIN = false; static_assert(ACT == 0 || ACT == 1, "EpiBf16: ACT is 0 (none) or 1 (gelu_pk)");
    bf16_t* O; int ldc; const float* bias; int split_cols; size_t split_stride; float scale0;
    __device__ __forceinline__ void operator()(const f32x4 (&acc)[2][2][4][2], const Unit& u, int wr, int wc, int fr, int fq) const {
        const int row0 = u.pm * BM + wr * 64 + fr; int colt = u.pn * BM; bf16_t* base = O;
        float sc = 1.f; if (split_cols) { const int t = colt / split_cols; base += (size_t)t * split_stride; colt -= t * split_cols; if (t == 0) sc = scale0; }
        const int col0 = colt + wc * 32 + 8 * fq, bcol0 = u.pn * BM + wc * 32 + 8 * fq;
        f32x4 bv[2][2];
#pragma unroll
        for (int bj = 0; bj < 2; ++bj)
#pragma unroll
            for (int n = 0; n < 2; ++n) bv[bj][n] = bias ? *(const f32x4*)(bias + bcol0 + bj * HALF + 4 * n) : (f32x4){0.f, 0.f, 0.f, 0.f};
#pragma unroll
        for (int ai = 0; ai < 2; ++ai)
#pragma unroll
            for (int m = 0; m < 4; ++m) { bf16_t* rowp = base + (size_t)(row0 + ai * HALF + m * 16) * ldc + col0;
#pragma unroll
                for (int bj = 0; bj < 2; ++bj) { f32x4 v0 = acc[ai][bj][m][0] + bv[bj][0], v1 = acc[ai][bj][m][1] + bv[bj][1];
                    if (ACT == 1) { f32x2 a = gelu_pk((f32x2){v0[0], v0[1]}), b = gelu_pk((f32x2){v0[2], v0[3]}), c = gelu_pk((f32x2){v1[0], v1[1]}), d = gelu_pk((f32x2){v1[2], v1[3]});
                        v0 = (f32x4){a.x, a.y, b.x, b.y}; v1 = (f32x4){c.x, c.y, d.x, d.y}; }
                    v0 = v0 * sc; v1 = v1 * sc; u32x4 w; w.x = cvt_pk_bf16(v0[0], v0[1]); w.y = cvt_pk_bf16(v0[2], v0[3]); w.z = cvt_pk_bf16(v1[0], v1[1]); w.w = cvt_pk_bf16(v1[2], v1[3]);
                    *(u32x4*)(rowp + bj * HALF) = w; } }
    }
};
template <class Epi, class Sched, bool ALIGN_EPI = false, bool SP2 = false>
__device__ __forceinline__ void gemm_phase(PG8_LAS unsigned char* lds, const Gemm g, const Sched& S, const Epi& E) {
    const int tid = fresh_tid(), wid = __builtin_amdgcn_readfirstlane(tid >> 6), lane = tid & 63, wr = wid >> 2, wc = wid & 3, fr = lane & 15, fq = lane >> 4;
    const int K = g.K, nt = K / BK;
    unsigned voffA[2], voffB[2];
#pragma unroll
    for (int i = 0; i < 2; ++i) { int R, C; stage_rc(tid * 16 + i * 8192, R, C); const int Rb = Epi::PERM ? ((R & ~31) + perm32(R & 31)) : R;
        voffA[i] = (unsigned)(R * g.lda + C) * 2u; voffB[i] = (unsigned)(Rb * g.ldb + C) * 2u; }
    const size_t kstep = (size_t)(BK * 2);
    const size_t hstepA = (size_t)HALF * g.lda * 2, hstepB = (size_t)HALF * g.ldb * 2;
    const size_t tstepA = 2 * hstepA, tstepB = 2 * hstepB;
    const unsigned ldsw = (unsigned)wid * 1024u;
    const int aoff = lds_byte(wr * 64 + fr, fq * 8), boff = lds_byte(wc * 32 + fr, fq * 8);
#define PG8_SA(b, h) (((b) * 2 + (h)) * HTB)
#define PG8_SB(b, h) ((4 + (b) * 2 + (h)) * HTB)
#define PG8_STAGE(bufoff, gbase, voff) do { _Pragma("unroll") for (int _i = 0; _i < 2; ++_i) \
        __builtin_amdgcn_global_load_lds((const unsigned*)((const char*)(gbase) + (voff)[_i]), (PG8_LAS unsigned*)(lds + (bufoff) + ldsw + _i * 8192), 16, 0, 0); } while (0)
#define PG8_LDA(dst, b, h) do { _Pragma("unroll") for (int m = 0; m < 4; ++m) _Pragma("unroll") for (int k = 0; k < 2; ++k) dst[m][k] = *(const PG8_LAS bf16x8*)(lds + PG8_SA(b, h) + aoff + m * 2048 + k * 1024); } while (0)
#define PG8_LDB(dst, b, h) do { _Pragma("unroll") for (int n = 0; n < 2; ++n) _Pragma("unroll") for (int k = 0; k < 2; ++k) dst[n][k] = *(const PG8_LAS bf16x8*)(lds + PG8_SB(b, h) + boff + n * 2048 + k * 1024); } while (0)
#define PG8_MMA(ai, bj, At, Bt) do { __builtin_amdgcn_s_setprio(1); _Pragma("unroll") for (int m = 0; m < 4; ++m) _Pragma("unroll") for (int n = 0; n < 2; ++n) _Pragma("unroll") for (int k = 0; k < 2; ++k) \
        acc[ai][bj][m][n] = __builtin_amdgcn_mfma_f32_16x16x32_bf16(Bt[n][k], At[m][k], acc[ai][bj][m][n], 0, 0, 0); __builtin_amdgcn_s_setprio(0); } while (0)
#define PG8_WAIT_V(n) asm volatile("s_waitcnt vmcnt(" #n ")" ::: "memory")
#define PG8_WAIT_L(n) asm volatile("s_waitcnt lgkmcnt(" #n ")" ::: "memory")
#define PG8_BAR __builtin_amdgcn_s_barrier()
#define PG8_SCHED __builtin_amdgcn_sched_barrier(0)
    Unit cur, nxt; int ui = 0;
    if (!S.next(0, cur)) return;
    f32x4 acc[2][2][4][2];
#pragma unroll
    for (int a = 0; a < 2; ++a)
#pragma unroll
        for (int b = 0; b < 2; ++b)
#pragma unroll
            for (int m = 0; m < 4; ++m)
#pragma unroll
                for (int n = 0; n < 2; ++n) acc[a][b][m][n] = (f32x4){0.f, 0.f, 0.f, 0.f};
    bf16x8 At[4][2], B0[2][2], B1[2][2];
    const char* cA = (const char*)g.A + (size_t)cur.pm * tstepA; const char* cB = (const char*)g.Bt + (size_t)cur.pn * tstepB;
    S.a_ready(cur);
    if constexpr (SP2) {
        PG8_STAGE(PG8_SB(0, 0), cB, voffB); PG8_STAGE(PG8_SB(0, 1), cB + hstepB, voffB); PG8_STAGE(PG8_SA(0, 0), cA, voffA); PG8_STAGE(PG8_SA(0, 1), cA + hstepA, voffA);
        if (wr == 1) PG8_BAR;
        PG8_WAIT_V(2); PG8_BAR;
        PG8_STAGE(PG8_SB(1, 0), cB + kstep, voffB); PG8_STAGE(PG8_SA(1, 0), cA + kstep, voffA); PG8_STAGE(PG8_SB(1, 1), cB + hstepB + kstep, voffB);
        PG8_WAIT_V(6); PG8_BAR;
    } else {
        PG8_STAGE(PG8_SB(0, 0), cB, voffB); PG8_STAGE(PG8_SA(0, 0), cA, voffA); PG8_STAGE(PG8_SB(0, 1), cB + hstepB, voffB); PG8_STAGE(PG8_SA(0, 1), cA + hstepA, voffA);
        if (wr == 1) PG8_BAR;
        PG8_WAIT_V(4); PG8_BAR;
        PG8_STAGE(PG8_SB(1, 0), cB + kstep, voffB); PG8_STAGE(PG8_SA(1, 0), cA + kstep, voffA); PG8_STAGE(PG8_SB(1, 1), cB + hstepB + kstep, voffB);
        PG8_WAIT_V(6); PG8_BAR;
    }
    for (;;) {
        const bool has_next = S.next(ui + 1, nxt);
        const char* nA = has_next ? (const char*)g.A + (size_t)nxt.pm * tstepA : cA; const char* nB = has_next ? (const char*)g.Bt + (size_t)nxt.pn * tstepB : cB;
        for (int t = 0; t < nt; t += 2) {
            const bool last = (t == nt - 2);
            const char* a1 = cA + (size_t)(t + 1) * kstep;
            const char* a2 = last ? nA : cA + (size_t)(t + 2) * kstep; const char* b2 = last ? nB : cB + (size_t)(t + 2) * kstep;
            const char* a3 = a2 + kstep; const char* b3 = b2 + kstep;
            if (last && has_next) S.a_ready(nxt);
            if constexpr (SP2) {
            PG8_LDB(B0, 0, 0); PG8_LDB(B1, 0, 1); PG8_SCHED; PG8_LDA(At, 0, 0); PG8_STAGE(PG8_SA(1, 1), a1 + hstepA, voffA);
            PG8_WAIT_V(8); PG8_WAIT_L(0); PG8_BAR; PG8_MMA(0, 0, At, B0); PG8_MMA(0, 1, At, B1); PG8_BAR; PG8_SCHED;
            PG8_LDA(At, 0, 1); PG8_STAGE(PG8_SB(0, 0), b2, voffB); PG8_STAGE(PG8_SB(0, 1), b2 + hstepB, voffB); PG8_STAGE(PG8_SA(0, 0), a2, voffA);
            PG8_WAIT_V(8); PG8_WAIT_L(0); PG8_BAR; PG8_MMA(1, 0, At, B0); PG8_MMA(1, 1, At, B1); PG8_BAR; PG8_SCHED;
            PG8_LDB(B0, 1, 0); PG8_LDB(B1, 1, 1); PG8_SCHED; PG8_LDA(At, 1, 0); PG8_STAGE(PG8_SA(0, 1), a2 + hstepA, voffA);
            PG8_WAIT_V(8); PG8_WAIT_L(0); PG8_BAR; PG8_MMA(0, 0, At, B0); PG8_MMA(0, 1, At, B1); PG8_BAR; PG8_SCHED;
            PG8_LDA(At, 1, 1); PG8_STAGE(PG8_SB(1, 0), b3, voffB); PG8_STAGE(PG8_SB(1, 1), b3 + hstepB, voffB); PG8_STAGE(PG8_SA(1, 0), a3, voffA);
            PG8_WAIT_V(8); PG8_WAIT_L(0); PG8_BAR; PG8_MMA(1, 0, At, B0); PG8_MMA(1, 1, At, B1); PG8_BAR; PG8_SCHED;
            } else {
            PG8_LDB(B0, 0, 0); PG8_SCHED; PG8_LDA(At, 0, 0); PG8_STAGE(PG8_SA(1, 1), a1 + hstepA, voffA);
            PG8_WAIT_L(8); PG8_BAR; PG8_WAIT_L(0); PG8_MMA(0, 0, At, B0); PG8_BAR; PG8_SCHED;
            PG8_LDB(B1, 0, 1); PG8_STAGE(PG8_SB(0, 0), b2, voffB);
            PG8_BAR; PG8_WAIT_L(0); PG8_MMA(0, 1, At, B1); PG8_BAR;
            PG8_LDA(At, 0, 1); PG8_STAGE(PG8_SA(0, 0), a2, voffA);
            PG8_BAR; PG8_WAIT_L(0); PG8_MMA(1, 0, At, B0); PG8_BAR; PG8_SCHED;
            PG8_STAGE(PG8_SB(0, 1), b2 + hstepB, voffB);
            PG8_WAIT_V(6); PG8_BAR; PG8_MMA(1, 1, At, B1); PG8_BAR;
            PG8_LDB(B0, 1, 0); PG8_SCHED; PG8_LDA(At, 1, 0); PG8_STAGE(PG8_SA(0, 1), a2 + hstepA, voffA);
            PG8_WAIT_L(8); PG8_BAR; PG8_WAIT_L(0); PG8_MMA(0, 0, At, B0); PG8_BAR; PG8_SCHED;
            PG8_LDB(B1, 1, 1); PG8_STAGE(PG8_SB(1, 0), b3, voffB);
            PG8_BAR; PG8_WAIT_L(0); PG8_MMA(0, 1, At, B1); PG8_BAR;
            PG8_LDA(At, 1, 1); PG8_STAGE(PG8_SA(1, 0), a3, voffA);
            PG8_BAR; PG8_WAIT_L(0); PG8_MMA(1, 0, At, B0); PG8_BAR; PG8_SCHED;
            PG8_STAGE(PG8_SB(1, 1), b3 + hstepB, voffB);
            PG8_WAIT_V(6); PG8_BAR; PG8_MMA(1, 1, At, B1); PG8_BAR;
            }
        }
        if constexpr (ALIGN_EPI) { if (wr == 0) PG8_BAR; }
        if constexpr (!Epi::AFTER_DRAIN) { E(acc, cur, wr, wc, fr, fq); S.done(cur); }
        if (!has_next) break;
#pragma unroll
        for (int a = 0; a < 2; ++a)
#pragma unroll
            for (int b = 0; b < 2; ++b)
#pragma unroll
                for (int m = 0; m < 4; ++m)
#pragma unroll
                    for (int n = 0; n < 2; ++n) acc[a][b][m][n] = (f32x4){0.f, 0.f, 0.f, 0.f};
        cur = nxt; cA = nA; cB = nB; ++ui;
        if constexpr (ALIGN_EPI) { if (wr == 1) PG8_BAR; }
    }
    PG8_WAIT_V(0);
    if constexpr (!ALIGN_EPI) { if (wr == 0) PG8_BAR; }
    PG8_BAR;
    if constexpr (Epi::AFTER_DRAIN) { E.fused(acc, cur, wr, wc, fr, fq, lds, wid, lane); S.done(cur); }
#undef PG8_SA
#undef PG8_SB
#undef PG8_STAGE
#undef PG8_LDA
#undef PG8_LDB
#undef PG8_MMA
#undef PG8_WAIT_V
#undef PG8_WAIT_L
#undef PG8_BAR
#undef PG8_SCHED
}
}
namespace pg8 {
__device__ __forceinline__ float act_gelu_tanh(float x) {
    const float u = x * (1.0f + 0.044715f * x * x) * (-2.0f * 0.7978845608028654f * 1.4426950408889634f);
    return x * __builtin_amdgcn_rcpf(1.0f + __builtin_amdgcn_exp2f(u));
}
__device__ __forceinline__ float act_silu(float x) { return x * __builtin_amdgcn_rcpf(1.0f + __builtin_amdgcn_exp2f(x * -1.4426950408889634f)); }
template <int ACT> __device__ __forceinline__ float act_apply(float x) { if (ACT == 1) return act_gelu_tanh(x); if (ACT == 2) return act_silu(x); return x; }

constexpr size_t UNIT = (size_t)64 << 20;

struct Epi1 {
    static constexpr bool PERM = true, AFTER_DRAIN = false;
    unsigned char* ws; unsigned char* outb; float qscale;
    __device__ __forceinline__ void operator()(const f32x4 (&acc)[2][2][4][2], const Unit& u, int wr, int wc, int fr, int fq) const {
        const int seg = u.pn >> 2; int colt = (u.pn & 3) * BM; int ldc = 1024; float sc = 1.f;
        unsigned char* bb = ws + (size_t)seg * UNIT;
        if (seg == 0) sc = qscale;
        if (seg == 3) { bb = ws + 3 * UNIT; ldc = 2048; }
        if (seg == 4) { bb = outb; }
        if (seg == 5) { bb = outb + UNIT; }
        if (seg == 6) { bb = ws + 3 * UNIT; ldc = 2048; colt += 1024; }
        bf16_t* base = (bf16_t*)bb;
        const int row0 = u.pm * BM + wr * 64 + fr, col0 = colt + wc * 32 + 8 * fq;
#pragma unroll
        for (int ai = 0; ai < 2; ++ai)
#pragma unroll
            for (int m = 0; m < 4; ++m) { bf16_t* rowp = base + (size_t)(row0 + ai * HALF + m * 16) * ldc + col0;
#pragma unroll
                for (int bj = 0; bj < 2; ++bj) { const f32x4 v0 = acc[ai][bj][m][0] * sc, v1 = acc[ai][bj][m][1] * sc;
                    u32x4 w; w.x = cvt_pk_bf16(v0[0], v0[1]); w.y = cvt_pk_bf16(v0[2], v0[3]); w.z = cvt_pk_bf16(v1[0], v1[1]); w.w = cvt_pk_bf16(v1[2], v1[3]);
                    *(u32x4*)(rowp + bj * HALF) = w; } }
    }
};
struct EpiUZ {
    static constexpr bool PERM = true, AFTER_DRAIN = false;
    bf16_t* U; bf16_t* SZ;
    __device__ __forceinline__ void operator()(const f32x4 (&acc)[2][2][4][2], const Unit& u, int wr, int wc, int fr, int fq) const {
        bf16_t* base = (u.pn >= 8) ? SZ : U; const int colt = (u.pn & 7) * BM;
        const int row0 = u.pm * BM + wr * 64 + fr, col0 = colt + wc * 32 + 8 * fq;
#pragma unroll
        for (int ai = 0; ai < 2; ++ai)
#pragma unroll
            for (int m = 0; m < 4; ++m) { bf16_t* rowp = base + (size_t)(row0 + ai * HALF + m * 16) * 2048 + col0;
#pragma unroll
                for (int bj = 0; bj < 2; ++bj) { f32x4 v0 = acc[ai][bj][m][0], v1 = acc[ai][bj][m][1];
                    u32x4 w; w.x = cvt_pk_bf16(v0[0], v0[1]); w.y = cvt_pk_bf16(v0[2], v0[3]); w.z = cvt_pk_bf16(v1[0], v1[1]); w.w = cvt_pk_bf16(v1[2], v1[3]);
                    *(u32x4*)(rowp + bj * HALF) = w; } }
    }
};
template <int ACT, bool CSQ> struct EpiT {
    static constexpr bool PERM = true, AFTER_DRAIN = false;
    bf16_t* O; int ldc; float* csq; int ntok;
    __device__ __forceinline__ void operator()(const f32x4 (&acc)[2][2][4][2], const Unit& u, int wr, int wc, int fr, int fq) const {
        const int row0 = u.pm * BM + wr * 64 + fr, col0 = u.pn * BM + wc * 32 + 8 * fq;
        f32x4 cs[2][2];
#pragma unroll
        for (int bj = 0; bj < 2; ++bj) { cs[bj][0] = (f32x4){0.f, 0.f, 0.f, 0.f}; cs[bj][1] = (f32x4){0.f, 0.f, 0.f, 0.f}; }
#pragma unroll
        for (int ai = 0; ai < 2; ++ai)
#pragma unroll
            for (int m = 0; m < 4; ++m) { bf16_t* rowp = O + (size_t)(row0 + ai * HALF + m * 16) * ldc + col0;
#pragma unroll
                for (int bj = 0; bj < 2; ++bj) { f32x4 v0 = acc[ai][bj][m][0], v1 = acc[ai][bj][m][1];
#pragma unroll
                    for (int e = 0; e < 4; ++e) { v0[e] = act_apply<ACT>(v0[e]); v1[e] = act_apply<ACT>(v1[e]); }
                    if (CSQ) { cs[bj][0] += v0 * v0; cs[bj][1] += v1 * v1; }
                    u32x4 w; w.x = cvt_pk_bf16(v0[0], v0[1]); w.y = cvt_pk_bf16(v0[2], v0[3]); w.z = cvt_pk_bf16(v1[0], v1[1]); w.w = cvt_pk_bf16(v1[2], v1[3]);
                    *(u32x4*)(rowp + bj * HALF) = w; } }
        if (CSQ) {
#pragma unroll
            for (int bj = 0; bj < 2; ++bj)
#pragma unroll
                for (int n = 0; n < 2; ++n) { f32x4 s = cs[bj][n];
#pragma unroll
                    for (int e = 0; e < 4; ++e) { float t = s[e]; t += __shfl_xor(t, 1); t += __shfl_xor(t, 2); t += __shfl_xor(t, 4); t += __shfl_xor(t, 8); s[e] = t; }
                    if (fr == 0) *(f32x4*)(csq + (size_t)(2 * u.pm + wr) * ntok + col0 + bj * HALF + 4 * n) = s; }
        }
    }
};
struct EpiY {
    static constexpr bool PERM = true, AFTER_DRAIN = false;
    bf16_t* O; float* rsq; int nrow;
    __device__ __forceinline__ void operator()(const f32x4 (&acc)[2][2][4][2], const Unit& u, int wr, int wc, int fr, int fq) const {
        const int row0 = u.pm * BM + wr * 64 + fr, col0 = u.pn * BM + wc * 32 + 8 * fq;
#pragma unroll
        for (int ai = 0; ai < 2; ++ai)
#pragma unroll
            for (int m = 0; m < 4; ++m) { const int row = row0 + ai * HALF + m * 16; bf16_t* rowp = O + (size_t)row * 1024 + col0; float s = 0.f;
#pragma unroll
                for (int bj = 0; bj < 2; ++bj) { const f32x4 v0 = acc[ai][bj][m][0], v1 = acc[ai][bj][m][1];
                    s += (v0[0] * v0[0] + v0[1] * v0[1]) + (v0[2] * v0[2] + v0[3] * v0[3]) + (v1[0] * v1[0] + v1[1] * v1[1]) + (v1[2] * v1[2] + v1[3] * v1[3]);
                    u32x4 w; w.x = cvt_pk_bf16(v0[0], v0[1]); w.y = cvt_pk_bf16(v0[2], v0[3]); w.z = cvt_pk_bf16(v1[0], v1[1]); w.w = cvt_pk_bf16(v1[2], v1[3]);
                    *(u32x4*)(rowp + bj * HALF) = w; }
                s += __shfl_xor(s, 16); s += __shfl_xor(s, 32);
                if (fq == 0) rsq[(size_t)(4 * u.pn + wc) * nrow + row] = s; }
    }
};
}
#include <hip/hip_bf16.h>
#include <cmath>
namespace attn_body {
using bf16=__hip_bfloat16;
using bf16x8=__attribute__((ext_vector_type(8)))short;
using s16x4=__attribute__((ext_vector_type(4)))short;
using f32x16=__attribute__((ext_vector_type(16)))float;
using u32x4=__attribute__((ext_vector_type(4)))unsigned;
constexpr int BATCH=8,NHEAD=16,SEQ=4096,D=64,DM=1024;
constexpr int NW=8,QBLK=32,QB=QBLK*NW,KVBLK=64,NQB=SEQ/QB;
constexpr int ATTN_PITCH=DM, ATTN_UNIT_ROWS=QB;
__device__ __forceinline__ int crow(int r,int hi){return (r&3)+8*(r>>2)+4*hi;}
#define SBAR() __builtin_amdgcn_sched_barrier(0)
__device__ __forceinline__ void cmask(f32x16&p0,f32x16&p1,int jb,int qrel,int hi){
  const float NEG=-INFINITY; int kb=64*jb+4*hi;
  #pragma unroll
  for(int r=0;r<16;++r){int kv=kb+(r&3)+8*(r>>2); if(kv>qrel)p0[r]=NEG; if(kv+32>qrel)p1[r]=NEG;}
}

constexpr int NSLOT=3, SLOTB=8192;
constexpr int LDS_K=0, LDS_V=NSLOT*SLOTB, LDS_WS=2*NSLOT*SLOTB, LDS_OST=LDS_WS+NW*64*4, LDS_BYTES=LDS_OST+NW*4096;
constexpr float C2=0.125f*1.4426950408889634f;
__device__ __forceinline__ void glds16(const void*gsrc,unsigned lds_dst){unsigned keep;
  asm volatile("s_mov_b32 %0, m0\n\ts_mov_b32 m0, %2\n\ts_nop 0\n\tglobal_load_lds_dwordx4 %1, off\n\ts_mov_b32 m0, %0":"=&s"(keep):"v"(gsrc),"s"(lds_dst):"memory");}
__device__ __forceinline__ float max3f(float a,float b,float c){float r;asm("v_max3_f32 %0, %1, %2, %3":"=v"(r):"v"(a),"v"(b),"v"(c));return r;}
__device__ __forceinline__ float max2f(float a,float b){float r;asm("v_max_f32_e32 %0, %1, %2":"=v"(r):"v"(a),"v"(b));return r;}
__device__ __forceinline__ float fadd_s(float a,float b){float r;asm("v_add_f32_e32 %0, %1, %2":"=v"(r):"v"(a),"v"(b));return r;}
__device__ __forceinline__ float fsub_s(float a,float b){float r;asm("v_sub_f32_e32 %0, %1, %2":"=v"(r):"v"(a),"v"(b));return r;}
typedef float f32x2_t __attribute__((ext_vector_type(2))); typedef __bf16 bf16x2_t __attribute__((ext_vector_type(2)));
__device__ __forceinline__ unsigned cvtpk_s(float lo,float hi){f32x2_t v={lo,hi};bf16x2_t b=__builtin_convertvector(v,bf16x2_t);return __builtin_bit_cast(unsigned,b);}
#define WAIT_BAR(N) asm volatile("s_waitcnt vmcnt(" #N ") lgkmcnt(0)\n\ts_barrier":::"memory")

__device__ __forceinline__ void qkt(f32x16&p0,f32x16&p1,const char*Kslot,const bf16x8*qr,const f32x16&negm,int r32,int hi){
  const char*kb=Kslot+hi*1024+r32*16;
  #pragma unroll
  for(int d0=0;d0<4;++d0){
    const bf16x8 b0=*reinterpret_cast<const bf16x8*>(kb+d0*2048);
    const bf16x8 b1=*reinterpret_cast<const bf16x8*>(kb+d0*2048+512);
    if(d0==0){p0=__builtin_amdgcn_mfma_f32_32x32x16_bf16(b0,qr[0],negm,0,0,0);p1=__builtin_amdgcn_mfma_f32_32x32x16_bf16(b1,qr[0],negm,0,0,0);}
    else{p0=__builtin_amdgcn_mfma_f32_32x32x16_bf16(b0,qr[d0],p0,0,0,0);p1=__builtin_amdgcn_mfma_f32_32x32x16_bf16(b1,qr[d0],p1,0,0,0);}}
}
typedef __attribute__((address_space(3))) const char* lds_cptr;
typedef short v4i16_t __attribute__((ext_vector_type(4)));
__device__ __forceinline__ void kload8(bf16x8*kf,lds_cptr kp){
  kf[0]=*(const __attribute__((address_space(3))) bf16x8*)(kp);      kf[1]=*(const __attribute__((address_space(3))) bf16x8*)(kp+512);
  kf[2]=*(const __attribute__((address_space(3))) bf16x8*)(kp+2048); kf[3]=*(const __attribute__((address_space(3))) bf16x8*)(kp+2560);
  kf[4]=*(const __attribute__((address_space(3))) bf16x8*)(kp+4096); kf[5]=*(const __attribute__((address_space(3))) bf16x8*)(kp+4608);
  kf[6]=*(const __attribute__((address_space(3))) bf16x8*)(kp+6144); kf[7]=*(const __attribute__((address_space(3))) bf16x8*)(kp+6656);
}
__device__ __forceinline__ void kload2(bf16x8*kf,lds_cptr kp,int j){ kf[2*j]=*(const __attribute__((address_space(3))) bf16x8*)(kp+j*2048); kf[2*j+1]=*(const __attribute__((address_space(3))) bf16x8*)(kp+j*2048+512); }
__device__ __forceinline__ s16x4 vtr(lds_cptr p){ return __builtin_bit_cast(s16x4,__builtin_amdgcn_ds_read_tr16_b64_v4i16((__attribute__((address_space(3))) v4i16_t*)p)); }
__device__ __forceinline__ float rowmax(const f32x16&p0,const f32x16&p1){
  float a=max3f(p0[0],p0[1],p1[0]),b=max3f(p0[2],p0[3],p1[1]);a=max3f(a,p1[2],p1[3]);
  #pragma unroll
  for(int r=4;r<16;r+=4){a=max3f(a,p0[r],p0[r+1]);b=max3f(b,p0[r+2],p0[r+3]);a=max3f(a,p1[r],p1[r+1]);b=max3f(b,p1[r+2],p1[r+3]);}
  const float m=max2f(a,b);
  auto rr=__builtin_amdgcn_permlane32_swap(__float_as_uint(m),__float_as_uint(m),false,false);
  return max2f(__uint_as_float(rr[0]),__uint_as_float(rr[1]));
}
__device__ __forceinline__ void pv(f32x16*o,int vb,bf16x8 pa0,bf16x8 pa1,bf16x8 pa2,bf16x8 pa3){
  #pragma unroll
  for(int d0=0;d0<2;++d0){s16x4 lo[4],hi[4];
    #pragma unroll
    for(int ks=0;ks<4;++ks){
      asm volatile("ds_read_b64_tr_b16 %0,%1 offset:%c2":"=&v"(lo[ks]):"v"(vb),"i"(d0*4096+ks*1024):"memory");
      asm volatile("ds_read_b64_tr_b16 %0,%1 offset:%c2":"=&v"(hi[ks]):"v"(vb),"i"(d0*4096+ks*1024+512):"memory");}
    asm volatile("s_waitcnt lgkmcnt(0)":::"memory");SBAR();
    #define PK(k) (bf16x8){lo[k][0],lo[k][1],lo[k][2],lo[k][3],hi[k][0],hi[k][1],hi[k][2],hi[k][3]}
    o[d0]=__builtin_amdgcn_mfma_f32_32x32x16_bf16(pa0,PK(0),o[d0],0,0,0);
    o[d0]=__builtin_amdgcn_mfma_f32_32x32x16_bf16(pa1,PK(1),o[d0],0,0,0);
    o[d0]=__builtin_amdgcn_mfma_f32_32x32x16_bf16(pa2,PK(2),o[d0],0,0,0);
    o[d0]=__builtin_amdgcn_mfma_f32_32x32x16_bf16(pa3,PK(3),o[d0],0,0,0);
    #undef PK
  }
}

#ifndef ATTN_STORE16
#define ATTN_STORE16(p,v) (*(u32x4*)(p)=(v))
#endif
template<int THRL> __device__ __forceinline__ void attn_unit(int b,int qc,int kc,int vc,int oc,int qb,const bf16*Q,const bf16*__restrict__ K,const bf16*__restrict__ V,bf16*O,char*shm){
  const int tid=fresh_tid(),lane=tid&63,r32=lane&31,hi=lane>>5; const int wid=__builtin_amdgcn_readfirstlane(tid>>6);
  const long rowbase=(long)b*SEQ; const int q0=qb*QB;
  const bf16*Qw=Q+(rowbase+q0+wid*QBLK)*DM+qc;
  const bf16*Kh=K+rowbase*DM+kc,*Vh=V+rowbase*DM+vc;
  const unsigned lds0=(unsigned)(uintptr_t)shm;
  float*wsf=(float*)(shm+LDS_WS)+wid*64;
  const bf16*ksrc=Kh+(long)lane*DM+wid*8;
  const bf16*vsrc=Vh+(long)(16*(wid&3)+(lane>>2))*DM+(wid>>2)*32+(lane&3)*8;
  const unsigned kdst=lds0+LDS_K+wid*1024, vdst=lds0+LDS_V+wid*1024;
  #define DMA_K(t,slot) glds16(ksrc+(long)(t)*KVBLK*DM,(unsigned)__builtin_amdgcn_readfirstlane(kdst+(slot)))
  #define DMA_V(t,slot) glds16(vsrc+(long)(t)*KVBLK*DM,(unsigned)__builtin_amdgcn_readfirstlane(vdst+(slot)))
  const int vb0=(int)(lds0+LDS_V)+((lane>>4)&1)*32+(lane&3)*8+(4*hi+((lane&15)>>2))*64;
  const char*Kbase=shm+LDS_K; bf16x8 kf[8];
  const lds_cptr shm3=(lds_cptr)shm; const lds_cptr kp0=shm3+LDS_K+hi*1024+r32*16; const lds_cptr vp0=shm3+LDS_V+((lane>>4)&1)*32+(lane&3)*8+(4*hi+((lane&15)>>2))*64;
  const int NT=(q0+QB)/KVBLK;
  DMA_K(0,0);DMA_V(0,0);DMA_K(1,SLOTB);
  bf16x8 qr[4];
  #pragma unroll
  for(int d0=0;d0<4;++d0)qr[d0]=*reinterpret_cast<const bf16x8*>(&Qw[(long)r32*DM+d0*16+hi*8]);
  float mhat=0.f,l_reg=0.f;f32x16 o[2];o[0]=f32x16{};o[1]=f32x16{};f32x16 negm=f32x16{};asm volatile("":"+v"(negm));
  const int qrel=wid*QBLK+r32;
  #define CMASK(P0,P1,t) do{int jb_=(t)-(NT-4); if(jb_>=0)cmask(P0,P1,jb_,qrel,hi);}while(0)
  bool resc=false;
  #define START(P0,P1) do{ const float rm=rowmax(P0,P1); resc=false; \
    { const float dl=rm; mhat=fadd_s(mhat,dl); \
      _Pragma("unroll") for(int r=0;r<16;++r){P0[r]=fsub_s(P0[r],dl);P1[r]=fsub_s(P1[r],dl);} \
      _Pragma("unroll") for(int r=0;r<16;++r)negm[r]=-mhat; asm volatile("":"+v"(negm)); } \
    _Pragma("unroll") for(int r=0;r<16;++r)P0[r]=__builtin_amdgcn_exp2f(P0[r]); }while(0)
  #define RESC() do{ if(resc){ asm volatile("s_waitcnt lgkmcnt(0)":::"memory"); \
      _Pragma("unroll") for(int d_=0;d_<2;++d_) _Pragma("unroll") for(int r=0;r<16;++r)o[d_][r]*=wsf[crow(r,hi)]; } }while(0)
  f32x16 pA0,pA1,pB0,pB1;
  int sl_prev=0,sl_cur=0,sl_next=SLOTB;
  #define ROT() do{sl_prev=sl_cur;sl_cur=sl_next;sl_next=(sl_next==(NSLOT-1)*SLOTB)?0:sl_next+SLOTB;}while(0)
  DMA_K(2,2*SLOTB);
  WAIT_BAR(3);
  qkt(pA0,pA1,Kbase,qr,negm,r32,hi);asm volatile("s_nop 15\n\ts_nop 7":"+v"(pA0),"+v"(pA1));CMASK(pA0,pA1,0);
  START(pA0,pA1);
  _Pragma("unroll") for(int r=0;r<16;++r)pA1[r]=__builtin_amdgcn_exp2f(pA1[r]);
  WAIT_BAR(0);
  DMA_K(3,0);DMA_V(1,SLOTB);
  ROT();
  kload8(kf,kp0+sl_cur);
  WAIT_BAR(2);
  s16x4 vlo[8],vhi[8]; u32x4 pw0,pw1,pw2,pw3;
  #define PKW(P,B) cvtpk_s(P[B],P[B+1])
  #define PAF(k) __builtin_bit_cast(bf16x8,pw##k)
  #define VFR(i) (bf16x8){vlo[i][0],vlo[i][1],vlo[i][2],vlo[i][3],vhi[i][0],vhi[i][1],vhi[i][2],vhi[i][3]}
  #define PIN(x) asm volatile("":"+v"(x))
  #define MX3(a,b,c) __builtin_fmaxf(__builtin_fmaxf((a),(b)),(c))
  #define GAPA(MF,A0,A1,A2,A3,W0,W1,PW) do{ MF; sacc+=A0; sacc+=A1; sacc+=A2; sacc+=A3; PIN(sacc); W0; W1; PIN(PW); SBAR(); }while(0)
  #define EX(v) __builtin_amdgcn_exp2f(v)
  #define GAPB(MF,X,B) do{ MF; X[B]=EX(X[B]); X[B+1]=EX(X[B+1]); X[B+2]=EX(X[B+2]); X[B+3]=EX(X[B+3]); PIN(X); SBAR(); }while(0)
  #define VRD(i) do{ vlo[i]=vtr(vp_+(((i)>>2)*4096+((i)&3)*1024)); vhi[i]=vtr(vp_+(((i)>>2)*4096+((i)&3)*1024+512)); }while(0)
  #define KRD(G,j) do{ if(G){ kload2(kf,kp0+sl_next,j); SBAR(); } }while(0)
  #define STEP(C0,C1,P0,P1,t,GK,GV,GL) do{ SBAR(); \
    const lds_cptr vp_=vp0+sl_prev; \
    VRD(0); SBAR(); float sacc=(P0[0]+P0[1]); \
    GAPA(C0=__builtin_amdgcn_mfma_f32_32x32x16_bf16(kf[0],qr[0],negm,0,0,0), P0[2],P0[3],P0[4],P0[5],     pw0[0]=PKW(P0,0), pw0[1]=PKW(P0,2), pw0); \
    VRD(4); SBAR(); GAPA(C1=__builtin_amdgcn_mfma_f32_32x32x16_bf16(kf[1],qr[0],negm,0,0,0), P0[6],P0[7],P0[8],P0[9],     pw0[2]=PKW(P0,4), pw0[3]=PKW(P0,6), pw0); \
    VRD(1); SBAR(); GAPA(C0=__builtin_amdgcn_mfma_f32_32x32x16_bf16(kf[2],qr[1],C0,0,0,0),   P0[10],P0[11],P0[12],P0[13], pw1[0]=PKW(P0,8), pw1[1]=PKW(P0,10), pw1); \
    VRD(5); SBAR(); GAPA(C1=__builtin_amdgcn_mfma_f32_32x32x16_bf16(kf[3],qr[1],C1,0,0,0),   P0[14],P0[15],P1[0],P1[1],   pw1[2]=PKW(P0,12),pw1[3]=PKW(P0,14), pw1); \
    VRD(2); SBAR(); GAPA(C0=__builtin_amdgcn_mfma_f32_32x32x16_bf16(kf[4],qr[2],C0,0,0,0),   P1[2],P1[3],P1[4],P1[5],     pw2[0]=PKW(P1,0), pw2[1]=PKW(P1,2), pw2); \
    VRD(6); SBAR(); GAPA(C1=__builtin_amdgcn_mfma_f32_32x32x16_bf16(kf[5],qr[2],C1,0,0,0),   P1[6],P1[7],P1[8],P1[9],     pw2[2]=PKW(P1,4), pw2[3]=PKW(P1,6), pw2); \
    VRD(3); SBAR(); GAPA(C0=__builtin_amdgcn_mfma_f32_32x32x16_bf16(kf[6],qr[3],C0,0,0,0),   P1[10],P1[11],P1[12],P1[13], pw3[0]=PKW(P1,8), pw3[1]=PKW(P1,10), pw3); \
    VRD(7); SBAR(); GAPA(C1=__builtin_amdgcn_mfma_f32_32x32x16_bf16(kf[7],qr[3],C1,0,0,0),   P1[14],P1[15],0.f,0.f,       pw3[2]=PKW(P1,12),pw3[3]=PKW(P1,14), pw3); \
    l_reg+=sacc; \
    if(GK){DMA_K((t)+3,sl_cur);} if(GV){DMA_V((t)+1,sl_next);} \
    CMASK(C0,C1,t); \
    { float a=MX3(C0[0],C0[1],C1[0]),b=MX3(C0[2],C0[3],C1[1]); a=MX3(a,C1[2],C1[3]); \
      _Pragma("unroll") for(int r=4;r<16;r+=4){a=MX3(a,C0[r],C0[r+1]);b=MX3(b,C0[r+2],C0[r+3]);a=MX3(a,C1[r],C1[r+1]);b=MX3(b,C1[r+2],C1[r+3]);} \
      float rm=__builtin_fmaxf(a,b); { auto rr=__builtin_amdgcn_permlane32_swap(__float_as_uint(rm),__float_as_uint(rm),false,false); rm=__builtin_fmaxf(__uint_as_float(rr[0]),__uint_as_float(rr[1])); } \
      resc=false; \
      if(__builtin_expect(__any(rm>(float)THRL),0)){ const float dl=__builtin_fmaxf(rm,0.f); mhat+=dl; \
        _Pragma("unroll") for(int r=0;r<16;++r){C0[r]-=dl;C1[r]-=dl;} \
        _Pragma("unroll") for(int r=0;r<16;++r)negm[r]=-mhat; asm volatile("":"+v"(negm)); \
        const float f=__builtin_amdgcn_exp2f(-dl); l_reg*=f; if(hi==0)wsf[r32]=f; resc=true; } } \
    SBAR(); \
    GAPB(o[0]=__builtin_amdgcn_mfma_f32_32x32x16_bf16(PAF(0),VFR(0),o[0],0,0,0), C0,0); \
    GAPB(o[1]=__builtin_amdgcn_mfma_f32_32x32x16_bf16(PAF(0),VFR(4),o[1],0,0,0), C0,4); \
    KRD(GL,0); GAPB(o[0]=__builtin_amdgcn_mfma_f32_32x32x16_bf16(PAF(1),VFR(1),o[0],0,0,0), C0,8); \
    KRD(GL,1); GAPB(o[1]=__builtin_amdgcn_mfma_f32_32x32x16_bf16(PAF(1),VFR(5),o[1],0,0,0), C0,12); \
    KRD(GL,2); GAPB(o[0]=__builtin_amdgcn_mfma_f32_32x32x16_bf16(PAF(2),VFR(2),o[0],0,0,0), C1,0); \
    KRD(GL,3); GAPB(o[1]=__builtin_amdgcn_mfma_f32_32x32x16_bf16(PAF(2),VFR(6),o[1],0,0,0), C1,4); \
    GAPB(o[0]=__builtin_amdgcn_mfma_f32_32x32x16_bf16(PAF(3),VFR(3),o[0],0,0,0), C1,8); \
    GAPB(o[1]=__builtin_amdgcn_mfma_f32_32x32x16_bf16(PAF(3),VFR(7),o[1],0,0,0), C1,12); \
    }while(0)
  int t=1;
  #undef CMASK
  #define CMASK(P0,P1,t) do{}while(0)
  for(;t+5<NT;t+=2){
    STEP(pB0,pB1,pA0,pA1,t,true,true,true);     WAIT_BAR(2); RESC(); ROT();
    STEP(pA0,pA1,pB0,pB1,t+1,true,true,true);   WAIT_BAR(2); RESC(); ROT();
  }
  #undef CMASK
  #define CMASK(P0,P1,t) do{int jb_=(t)-(NT-4); if(jb_>=0)cmask(P0,P1,jb_,qrel,hi);}while(0)
  #define ENDW(tt) do{ if((tt)+3<NT){WAIT_BAR(2);} else if((tt)+2<NT){WAIT_BAR(1);} else {WAIT_BAR(0);} }while(0)
  for(;t+1<NT;t+=2){
    STEP(pB0,pB1,pA0,pA1,t,(t+3<NT),(t+1<NT),(t+1<NT));       ENDW(t);   RESC(); ROT();
    STEP(pA0,pA1,pB0,pB1,t+1,(t+4<NT),(t+2<NT),(t+2<NT));     ENDW(t+1); RESC(); ROT();
  }
  STEP(pB0,pB1,pA0,pA1,NT-1,false,false,false); RESC();
  { float sacc=pB0[0]+pB0[1]; _Pragma("unroll") for(int r=2;r<16;++r)sacc+=pB0[r]; _Pragma("unroll") for(int r=0;r<16;++r)sacc+=pB1[r]; l_reg+=sacc;
    pw0=(u32x4){PKW(pB0,0),PKW(pB0,2),PKW(pB0,4),PKW(pB0,6)};pw1=(u32x4){PKW(pB0,8),PKW(pB0,10),PKW(pB0,12),PKW(pB0,14)};pw2=(u32x4){PKW(pB1,0),PKW(pB1,2),PKW(pB1,4),PKW(pB1,6)};pw3=(u32x4){PKW(pB1,8),PKW(pB1,10),PKW(pB1,12),PKW(pB1,14)};
    SBAR(); pv(o,vb0+sl_cur,PAF(0),PAF(1),PAF(2),PAF(3)); }
  #undef PKW
  #undef PAF
  #undef VFR
  #undef PIN
  #undef MX3
  #undef GAPA
  #undef GAPB
  #undef EX
  #undef VRD
  #undef KRD
  #undef STEP
  #undef ENDW
  {auto rr=__builtin_amdgcn_permlane32_swap(__float_as_uint(l_reg),__float_as_uint(l_reg),false,false);l_reg=__uint_as_float(rr[0])+__uint_as_float(rr[1]);}
  if(hi==0)wsf[32+r32]=l_reg;asm volatile("s_waitcnt lgkmcnt(0)":::"memory");
  float rli[16];
  #pragma unroll
  for(int r=0;r<16;++r)rli[r]=__builtin_amdgcn_rcpf(wsf[32+crow(r,hi)]);
  bf16*Ow=O+(rowbase+q0+wid*QBLK)*DM+oc;
  { bf16*stg=(bf16*)(shm+LDS_OST)+wid*2048;
    #pragma unroll
    for(int r=0;r<16;++r){const int orow=crow(r,hi);
      #pragma unroll
      for(int d0=0;d0<2;++d0)stg[orow*64+d0*32+r32]=__float2bfloat16(o[d0][r]*rli[r]);}
    asm volatile("s_waitcnt lgkmcnt(0)":::"memory");
    #pragma unroll
    for(int i=0;i<4;++i){const int row=i*8+(lane>>3),ch=lane&7; const u32x4 v=*(const u32x4*)(stg+row*64+ch*8); ATTN_STORE16(Ow+(long)row*DM+ch*8,v);} }
  asm volatile("s_waitcnt lgkmcnt(0)\n\ts_barrier":::"memory");
  #undef DMA_K
  #undef DMA_V
  #undef CMASK
  #undef START
  #undef RESC
  #undef ROT
}
constexpr int ATTN_LDS_BYTES=LDS_BYTES;
#undef SBAR
#undef WAIT_BAR
}
#define LAS __attribute__((address_space(3)))
#define XB_TMO      128
#define XB_XCNT(j)  (256  + 64 * (j))
#define XB_XSUB(j)  (1280 + 64 * (j))
#define XB_XGEN(j)  (2304 + 64 * (j))
#define XB_TOP      3328
#define XB_TOPGEN   3392
#define XCD_BAR_WORDS 3456
#define XB_SPIN_CAP (1u << 18)

__device__ __forceinline__ unsigned xb_ld(unsigned* p)              { return __hip_atomic_load(p, __ATOMIC_RELAXED, __HIP_MEMORY_SCOPE_AGENT); }
__device__ __forceinline__ unsigned xb_add(unsigned* p, unsigned v) { return __hip_atomic_fetch_add(p, v, __ATOMIC_RELAXED, __HIP_MEMORY_SCOPE_AGENT); }
__device__ __forceinline__ unsigned xb_xcc_id() { return (unsigned)__builtin_amdgcn_s_getreg((3 << 11) | 20) & 0xFu; }
#define XB_SPIN(cond, bar) do { unsigned _sp = 0; while (cond) { __builtin_amdgcn_s_sleep(1); \
    if ((++_sp & 255u) == 0u) { if (xb_ld(&(bar)[XB_TMO])) break; if (_sp > XB_SPIN_CAP) { atomicAdd(&(bar)[XB_TMO], 1u); break; } } } } while (0)

struct XcdBarrier {
    unsigned* bar; unsigned x;
    volatile LAS unsigned* st;
};

__device__ __forceinline__ XcdBarrier xcd_barrier_post(unsigned* bar, volatile LAS unsigned* st) {
    XcdBarrier b; b.bar = bar; b.x = xb_xcc_id(); b.st = st;
    if (fresh_tid() == 0) (void)xb_add(&bar[XB_XCNT(b.x)], 1u);
    return b;
}
__device__ __forceinline__ void xcd_barrier_complete(unsigned* bar, unsigned x, unsigned& nloc, unsigned& nx) {
    const unsigned G = gridDim.x * gridDim.y * gridDim.z;
    unsigned sum, cnt, mine, sp = 0u;
    for (;;) {
        sum = 0u; cnt = 0u; mine = 0u;
#pragma unroll
        for (unsigned j = 0; j < 16; ++j) { const unsigned c = xb_ld(&bar[XB_XCNT(j)]); sum += c; cnt += (c > 0u) ? 1u : 0u; mine = (j == x) ? c : mine; }
        if (sum == G) break;
        __builtin_amdgcn_s_sleep(1);
        if ((++sp & 255u) == 0u) { if (xb_ld(&bar[XB_TMO])) break; if (sp > XB_SPIN_CAP) { atomicAdd(&bar[XB_TMO], 1u); break; } }
    }
    nloc = mine > 0u ? mine : 1u; nx = cnt > 0u ? cnt : 1u;
}

__device__ __forceinline__ void xcd_barrier(const XcdBarrier& b) {
    asm volatile("s_waitcnt vmcnt(0)" ::: "memory");
    __syncthreads();
    if (fresh_tid() == 0) {
        unsigned* bar = b.bar;
        __builtin_amdgcn_s_waitcnt(0);
        unsigned nloc = b.st[0], nx = b.st[1];
        if (nloc == 0u) { xcd_barrier_complete(bar, b.x, nloc, nx); b.st[0] = nloc; b.st[1] = nx; }
        const unsigned old = xb_add(&bar[XB_XSUB(b.x)], 1u);
        const unsigned gen = old / nloc;
        if (old + 1u == (gen + 1u) * nloc) {
            __builtin_amdgcn_fence(__ATOMIC_RELEASE, "agent");
            asm volatile("s_waitcnt vmcnt(0)" ::: "memory");
            const unsigned og = xb_add(&bar[XB_TOP], 1u);
            const unsigned tg = og / nx;
            if (og + 1u == (tg + 1u) * nx) xb_add(&bar[XB_TOPGEN], 1u);
            else XB_SPIN(xb_ld(&bar[XB_TOPGEN]) == tg, bar);
            __builtin_amdgcn_fence(__ATOMIC_ACQUIRE, "agent");
            xb_add(&bar[XB_XGEN(b.x)], 1u);
            asm volatile("s_waitcnt vmcnt(0)" ::: "memory");
        } else {
            XB_SPIN(xb_ld(&bar[XB_XGEN(b.x)]) == gen, bar);
            __builtin_amdgcn_fence(__ATOMIC_ACQUIRE, "agent");
            asm volatile("s_waitcnt vmcnt(0)" ::: "memory");
        }
    }
    __syncthreads();
}

namespace attn_body {
struct AttnTensors { const bf16* Q; const bf16* K; const bf16* V; bf16* O; bf16* O2; };
struct AttnUnit { int bh; int qb; };
struct StaticOrder {
  int vcu, G;
  __device__ __forceinline__ explicit StaticOrder(int v,int g):vcu(v),G(g){}
  __device__ __forceinline__ bool next(int i,AttnUnit&u)const{ const int n=i*G+vcu; if(n>=4096)return false; const int cu=n&255, ii=n>>8, xcd=cu>>5, j=cu&31, s=j&7;
#if ATT_ORDER == 0
    u.bh=cu; { const int q0=(ii&1)?15-(ii>>1):(ii>>1); u.qb=(q0+s)&15; } return true; }
#else
    u.bh=((xcd*8+(ii>>1))<<2)|(j>>3); u.qb=(ii&1)?15-s:s; return true; }
#endif
};
template<class Sched,int THRL=8> __device__ __forceinline__ void attn_phase(char*lds,const AttnTensors&T,const Sched&S){
  AttnUnit u;
  for(int i=0;S.next(i,u);++i){ const int vv=u.bh, bhh=vv>>2, c=(vv>>1)&1, vh=vv&1, b=bhh>>3, h=bhh&7; attn_unit<THRL>(b,h*128+c*64,h*128+c*64,h*128+vh*64,h*128+vh*64,u.qb,T.Q,T.K,T.V,c?T.O2:T.O,lds); }
}
}

#define DI __device__ __forceinline__
#define LAS __attribute__((address_space(3)))
typedef unsigned short bf16_t;
typedef short bf16x8 __attribute__((ext_vector_type(8)));
typedef float f32x4 __attribute__((ext_vector_type(4)));
typedef float f32x16 __attribute__((ext_vector_type(16)));
typedef unsigned u32x4 __attribute__((ext_vector_type(4)));
typedef unsigned u32x2 __attribute__((ext_vector_type(2)));

constexpr int T_TOK = 32768, DM = 1024, SEQ = 4096, NB = 8;
constexpr size_t UNIT = (size_t)64 << 20, MiB = (size_t)1 << 20;
constexpr float EPS = 1e-6f;
constexpr int NTHR = 512;
constexpr int LDS_BYTES = 147456;
constexpr size_t WS_Q = 0, WS_K = UNIT, WS_V = 2 * UNIT, WS_Z = 3 * UNIT, WS_MVT = 5 * UNIT, WS_XN = 6 * UNIT, WS_MISC = 7 * UNIT;
constexpr size_t WS_Y0 = 0;
constexpr size_t WS_U = 0, WS_SZ = 2 * UNIT, WS_VT1 = 4 * UNIT, WS_Y1 = 2 * UNIT;
constexpr size_t MS_WT1 = WS_MISC, MS_WO0 = WS_MISC + 16 * MiB, MS_WUZ = WS_MISC + 20 * MiB, MS_WV = WS_MISC + 28 * MiB, MS_WO1 = WS_MISC + 32 * MiB;
constexpr size_t MS_GI = WS_MISC + 36 * MiB, MS_GF = MS_GI + 512 * 1024;
constexpr size_t MS_BCUM = WS_MISC + 37 * MiB, MS_A = MS_BCUM + 512 * 1024, MS_PM = MS_A + 512 * 1024, MS_WGT = MS_PM + 512 * 1024;
constexpr size_t MS_MPREV = WS_MISC + 39 * MiB, MS_DECAY = MS_MPREV + 4096, MS_DN = WS_MISC + 39 * MiB + 512 * 1024;
constexpr size_t MS_RSQ = WS_MISC + 40 * MiB, MS_CSQ = WS_MISC + 42 * MiB;
constexpr size_t MS_BAR = WS_MISC + 44 * MiB;
constexpr size_t WS_NEED = 8 * UNIT;

struct Params { const float* in[22]; float* out; unsigned char* ws; };

DI unsigned f2bf(float f) { unsigned u = __builtin_bit_cast(unsigned, f); return (u + 0x7fffu + ((u >> 16) & 1u)) >> 16; }
DI unsigned pk2(float lo, float hi) { return pg8::cvt_pk_bf16(lo, hi); }
DI float bflo(unsigned w) { return __builtin_bit_cast(float, w << 16); }
DI float bfhi(unsigned w) { return __builtin_bit_cast(float, w & 0xffff0000u); }
DI float bf2f(bf16_t h) { return __builtin_bit_cast(float, (unsigned)h << 16); }
DI void unpack8(const u32x4 w, float (&f)[8]) { f[0] = bflo(w.x); f[1] = bfhi(w.x); f[2] = bflo(w.y); f[3] = bfhi(w.y); f[4] = bflo(w.z); f[5] = bfhi(w.z); f[6] = bflo(w.w); f[7] = bfhi(w.w); }
DI u32x4 pack8(const float (&f)[8]) { u32x4 w; w.x = pk2(f[0], f[1]); w.y = pk2(f[2], f[3]); w.z = pk2(f[4], f[5]); w.w = pk2(f[6], f[7]); return w; }
DI float wave_sum(float v) {
#pragma unroll
    for (int o = 1; o < 64; o <<= 1) v += __shfl_xor(v, o);
    return v;
}
DI float silu_f(float x) { return x * __builtin_amdgcn_rcpf(1.0f + __builtin_amdgcn_exp2f(x * -1.4426950408889634f)); }
DI float sigmoid_f(float x) { return __builtin_amdgcn_rcpf(1.0f + __builtin_amdgcn_exp2f(x * -1.4426950408889634f)); }
DI int crow(int r, int hi) { return (r & 3) + 8 * (r >> 2) + 4 * hi; }
#define MFMA32(a, b, c) __builtin_amdgcn_mfma_f32_32x32x16_bf16((a), (b), (c), 0, 0, 0)
#define LDS_WAIT() asm volatile("s_waitcnt lgkmcnt(0)" ::: "memory")

DI void tr_item(const float* W, int ldw, int col0, int ncols, int K, bf16_t* WT, LAS float* scr, int item, int lane) {
    const int nblk = ncols / 32, kb = item / nblk, nb = item % nblk, k0 = 64 * kb, n0 = 32 * nb;
#pragma unroll 8
    for (int i = 0; i < 32; ++i) { const int kk = 2 * i + (lane >> 5); scr[kk * 33 + (lane & 31)] = W[(size_t)(k0 + kk) * ldw + col0 + n0 + (lane & 31)]; }
    LDS_WAIT(); asm volatile("" ::: "memory");
    const int c = lane & 7;
#pragma unroll
    for (int j = 0; j < 4; ++j) { const int n = (lane >> 3) + 8 * j; const LAS float* s = scr + (8 * c) * 33 + n;
        u32x4 o; o.x = pk2(s[0 * 33], s[1 * 33]); o.y = pk2(s[2 * 33], s[3 * 33]); o.z = pk2(s[4 * 33], s[5 * 33]); o.w = pk2(s[6 * 33], s[7 * 33]);
        *(u32x4*)(WT + (size_t)(n0 + n) * K + k0 + 8 * c) = o; }
    LDS_WAIT(); asm volatile("" ::: "memory");
}
DI void p0_prologue(const Params& P, LAS unsigned char* lds, int vcu, int G) {
    const int tid = fresh_tid(), lane = tid & 63, wave = tid >> 6;
    LAS float* scr = (LAS float*)(lds + wave * 16384);
    const int gw = vcu * 8 + wave, NGW = G * 8;
    unsigned char* ws = P.ws;
    constexpr int I_SEG = 16 * 32, I_O = 32 * 32, I_L1 = 16 * 64;
    constexpr int NITEMS = 8 * I_SEG + I_O + 3 * I_L1 + I_O;
    for (int it = gw; it < NITEMS; it += NGW) {
        int r = it;
        if (r < 8 * I_SEG) { const int seg = r / I_SEG; r -= seg * I_SEG;
            const int col0 = seg < 5 ? seg * 1024 : (seg == 5 ? 6152 : (seg == 6 ? 7176 : 5120));
            tr_item(P.in[2], 8200, col0, 1024, 1024, (bf16_t*)(ws + MS_WT1) + (size_t)seg * 1024 * 1024, scr, r, lane); continue; }
        r -= 8 * I_SEG;
        if (r < I_O) { tr_item(P.in[13], 1024, 0, 1024, 2048, (bf16_t*)(ws + MS_WO0), scr, r, lane); continue; }
        r -= I_O;
        if (r < I_L1) { tr_item(P.in[16], 6144, 0, 2048, 1024, (bf16_t*)(ws + MS_WUZ), scr, r, lane); continue; }
        r -= I_L1;
        if (r < I_L1) { tr_item(P.in[16], 6144, 4096, 2048, 1024, (bf16_t*)(ws + MS_WUZ) + (size_t)2048 * 1024, scr, r, lane); continue; }
        r -= I_L1;
        if (r < I_L1) { tr_item(P.in[16], 6144, 2048, 2048, 1024, (bf16_t*)(ws + MS_WV), scr, r, lane); continue; }
        r -= I_L1;
        tr_item(P.in[20], 1024, 0, 1024, 2048, (bf16_t*)(ws + MS_WO1), scr, r, lane);
    }
    const float* x = P.in[0]; const float* pre_g = P.in[1]; const float* w_in = P.in[2];
    f32x4 g4[4], wg[4][4][2];
#pragma unroll
    for (int j = 0; j < 4; ++j) { g4[j] = *(const f32x4*)(pre_g + 4 * lane + 256 * j);
#pragma unroll
        for (int e = 0; e < 4; ++e) { const float* p = w_in + (size_t)(4 * lane + 256 * j + e) * 8200 + 6144; wg[j][e][0] = *(const f32x4*)p; wg[j][e][1] = *(const f32x4*)(p + 4); } }
    const f32x4 bi = *(const f32x4*)P.in[3], bff = *(const f32x4*)P.in[4];
    bf16_t* XN = (bf16_t*)(ws + WS_XN); float* gi = (float*)(ws + MS_GI); float* gf = (float*)(ws + MS_GF);
    for (int m = gw; m < T_TOK; m += NGW) {
        const f32x4* xr = (const f32x4*)(x + (size_t)m * DM) + lane;
        f32x4 v[4]; float ss = 0.f;
#pragma unroll
        for (int j = 0; j < 4; ++j) { v[j] = xr[64 * j]; ss += (v[j].x * v[j].x + v[j].y * v[j].y) + (v[j].z * v[j].z + v[j].w * v[j].w); }
        const float rstd = 1.0f / sqrtf(wave_sum(ss) * (1.f / DM) + EPS);
        unsigned long long* o8 = (unsigned long long*)(XN + (size_t)m * DM) + lane;
        f32x4 p0 = (f32x4){0.f, 0.f, 0.f, 0.f}, p1 = p0;
#pragma unroll
        for (int j = 0; j < 4; ++j) { const f32x4 xn = v[j] * rstd * g4[j];
            o8[64 * j] = (unsigned long long)pk2(xn.x, xn.y) | ((unsigned long long)pk2(xn.z, xn.w) << 32);
#pragma unroll
            for (int e = 0; e < 4; ++e) { p0 += xn[e] * wg[j][e][0]; p1 += xn[e] * wg[j][e][1]; } }
#pragma unroll
        for (int e = 0; e < 4; ++e) { p0[e] = wave_sum(p0[e]); p1[e] = wave_sum(p1[e]); }
        if (lane == 0) { *(f32x4*)(gi + (size_t)m * 4) = p0 + bi; *(f32x4*)(gf + (size_t)m * 4) = p1 + bff; }
    }
}

DI void gate_scan(const Params& P, LAS unsigned char* lds, int bh) {
    const int tid = fresh_tid(), l15 = tid & 15, ch = tid >> 4; const int b = bh >> 2, h = bh & 3;
    LAS float* cbl = (LAS float*)lds; LAS float* cgm = cbl + 32; LAS float* cmp = cgm + 32; LAS float* cmn = cmp + 32;
    unsigned char* ws = P.ws;
    const float* gi = (const float*)(ws + MS_GI); const float* gf = (const float*)(ws + MS_GF);
    float cs[8], aa[8], pmx[8]; float run = 0.f;
#pragma unroll
    for (int j = 0; j < 8; ++j) { const size_t row = (size_t)b * SEQ + 8 * tid + j; const float f = gf[row * 4 + h];
        run += fminf(f, 0.f) - log1pf(expf(-fabsf(f))); cs[j] = run; aa[j] = gi[row * 4 + h]; }
    float incl = run;
#pragma unroll
    for (int d = 1; d < 16; d <<= 1) { const float v = __shfl_up(incl, d, 16); if (l15 >= d) incl += v; }
    const float excl = incl - run; const float bl = __shfl(incl, 15, 16);
    float amax = -INFINITY;
#pragma unroll
    for (int j = 0; j < 8; ++j) { cs[j] += excl; aa[j] -= cs[j]; amax = fmaxf(amax, aa[j]); pmx[j] = amax; }
    float pin = amax;
#pragma unroll
    for (int d = 1; d < 16; d <<= 1) { const float v = __shfl_up(pin, d, 16); if (l15 >= d) pin = fmaxf(pin, v); }
    float pex = __shfl_up(pin, 1, 16); if (l15 == 0) pex = -INFINITY;
    const float gmax = __shfl(pin, 15, 16);
    if (l15 == 0) { cbl[ch] = bl; cgm[ch] = bl + gmax; }
    __syncthreads();
    if (tid == 0) { float m = 0.f; float* mp = (float*)(ws + MS_MPREV) + bh * 32; float* dc = (float*)(ws + MS_DECAY) + bh * 32;
        for (int c = 0; c < 32; ++c) { cmp[c] = m; const float mn = fmaxf(cbl[c] + m, cgm[c]); const float de = expf(cbl[c] + m - mn); cmn[c] = mn; mp[c] = m; dc[c] = de; m = mn; } }
    __syncthreads();
    const float mprev = cmp[ch], mnew = cmn[ch];
    float pm[8], wv[8];
#pragma unroll
    for (int j = 0; j < 8; ++j) { pm[j] = fmaxf(fmaxf(mprev, pex), pmx[j]); wv[j] = expf(bl + aa[j] - mnew); }
    const size_t o = (size_t)bh * SEQ + 8 * tid;
    float* o_bc = (float*)(ws + MS_BCUM) + o; float* o_a = (float*)(ws + MS_A) + o; float* o_pm = (float*)(ws + MS_PM) + o; float* o_w = (float*)(ws + MS_WGT) + o;
    *(f32x4*)o_bc = (f32x4){cs[0], cs[1], cs[2], cs[3]}; *(f32x4*)(o_bc + 4) = (f32x4){cs[4], cs[5], cs[6], cs[7]};
    *(f32x4*)o_a = (f32x4){aa[0], aa[1], aa[2], aa[3]}; *(f32x4*)(o_a + 4) = (f32x4){aa[4], aa[5], aa[6], aa[7]};
    *(f32x4*)o_pm = (f32x4){pm[0], pm[1], pm[2], pm[3]}; *(f32x4*)(o_pm + 4) = (f32x4){pm[4], pm[5], pm[6], pm[7]};
    *(f32x4*)o_w = (f32x4){wv[0], wv[1], wv[2], wv[3]}; *(f32x4*)(o_w + 4) = (f32x4){wv[4], wv[5], wv[6], wv[7]};
    __syncthreads();
}

DI void conv8(const bf16_t* src, const float* cw, const float* cb, int b, int t, int ch, float (&o)[8]) {
    const f32x4 b0 = *(const f32x4*)(cb + ch), b1 = *(const f32x4*)(cb + ch + 4);
    float acc[8] = {b0.x, b0.y, b0.z, b0.w, b1.x, b1.y, b1.z, b1.w};
#pragma unroll
    for (int j = 0; j < 4; ++j) { const int tt = t - 3 + j;
        if (tt >= 0) { const u32x4 xw = *(const u32x4*)(src + ((size_t)b * SEQ + tt) * 1024 + ch); float xf[8]; unpack8(xw, xf);
            const f32x4 w0 = *(const f32x4*)(cw + j * 1024 + ch), w1 = *(const f32x4*)(cw + j * 1024 + ch + 4);
            acc[0] += w0.x * xf[0]; acc[1] += w0.y * xf[1]; acc[2] += w0.z * xf[2]; acc[3] += w0.w * xf[3];
            acc[4] += w1.x * xf[4]; acc[5] += w1.y * xf[5]; acc[6] += w1.z * xf[6]; acc[7] += w1.w * xf[7]; } }
#pragma unroll
    for (int e = 0; e < 8; ++e) o[e] = silu_f(acc[e]);
}

constexpr int KP = 136;
DI void mlstm_i_unit(const Params& P, LAS unsigned char* lds, int bh, int c) {
    const int tid = fresh_tid(), lane = tid & 63, w = tid >> 6, l32 = lane & 31, hi = lane >> 5;
    const int b = bh >> 2, h = bh & 3; const size_t tok0 = (size_t)b * SEQ + c * 128;
    unsigned char* ws = P.ws;
    const bf16_t* MQK = (const bf16_t*)P.out; const bf16_t* MVT = (const bf16_t*)(ws + WS_MVT);
    const float* wgt = (const float*)(ws + MS_WGT) + (size_t)bh * SEQ + c * 128;
    LAS bf16_t* KT = (LAS bf16_t*)lds;
    bf16x8 av[8]; { const bf16_t* vp = MVT + (size_t)(h * 256 + 32 * w + l32) * T_TOK + tok0 + 8 * hi;
#pragma unroll
        for (int ks = 0; ks < 8; ++ks) av[ks] = *(const bf16x8*)(vp + 16 * ks); }
    for (int i = 0; i < 4; ++i) { const int task = i * NTHR + tid, d8 = task & 15, s = task >> 4; float o[8];
        conv8(MQK, P.in[5], P.in[6], b, c * 128 + s, 512 + h * 128 + d8 * 8, o); const float wv = wgt[s];
#pragma unroll
        for (int e = 0; e < 8; ++e) KT[(d8 * 8 + e) * KP + s] = (bf16_t)f2bf(o[e] * wv); }
    __syncthreads();
    f32x16 acc[4];
#pragma unroll
    for (int db = 0; db < 4; ++db) { acc[db] = (f32x16){};
#pragma unroll
        for (int ks = 0; ks < 8; ++ks) { const bf16x8 bf = *(const LAS bf16x8*)(KT + (32 * db + l32) * KP + 16 * ks + 8 * hi); acc[db] = MFMA32(av[ks], bf, acc[db]); } }
    bf16_t* dst = (bf16_t*)(ws + WS_XN) + ((size_t)(bh * 32 + c) * 256) * 128;
#pragma unroll
    for (int db = 0; db < 4; ++db)
#pragma unroll
        for (int r = 0; r < 16; ++r) dst[(size_t)(32 * w + crow(r, hi)) * 128 + 32 * db + l32] = (bf16_t)f2bf(acc[db][r]);
    { const int d = tid >> 2, q = tid & 3; float s = 0.f;
        for (int j = 0; j < 32; ++j) s += bf2f(KT[d * KP + 32 * q + j]);
        s += __shfl_xor(s, 1); s += __shfl_xor(s, 2);
        if (q == 0) ((float*)(ws + MS_DN))[(size_t)(bh * 32 + c) * 128 + d] = s; }
    __syncthreads();
}

DI void mlstm_scan(const Params& P, int vcu, int G) {
    unsigned char* ws = P.ws; const float* decay = (const float*)(ws + MS_DECAY);
    for (int gid = vcu * NTHR + fresh_tid(); gid < 32 * 4096; gid += G * NTHR) {
        const int bh = gid >> 12, e8 = gid & 4095;
        bf16_t* p = (bf16_t*)(ws + WS_XN) + (size_t)bh * 32 * 32768 + (size_t)e8 * 8;
        float st[8] = {0.f, 0.f, 0.f, 0.f, 0.f, 0.f, 0.f, 0.f};
#pragma unroll 4
        for (int c = 0; c < 32; ++c) { const u32x4 v = *(const u32x4*)(p + (size_t)c * 32768); float f[8]; unpack8(v, f); const float de = decay[bh * 32 + c];
            *(u32x4*)(p + (size_t)c * 32768) = pack8(st);
#pragma unroll
            for (int e = 0; e < 8; ++e) st[e] = de * st[e] + f[e]; }
    }
    for (int gid = vcu * NTHR + fresh_tid(); gid < 32 * 128; gid += G * NTHR) {
        const int bh = gid >> 7, d = gid & 127; float* p = (float*)(ws + MS_DN) + (size_t)bh * 32 * 128 + d; float st = 0.f;
        for (int c = 0; c < 32; ++c) { const float v = p[c * 128]; p[c * 128] = st; st = decay[bh * 32 + c] * st + v; }
    }
}

constexpr int SP_F = 260;
DI void mlstm_out_unit(const Params& P, LAS unsigned char* lds, int bh, int c) {
    const int tid = fresh_tid(), lane = tid & 63, w = tid >> 6, l32 = lane & 31, hi = lane >> 5;
    const int b = bh >> 2, h = bh & 3; const size_t tok0 = (size_t)b * SEQ + c * 128;
    unsigned char* ws = P.ws;
    const bf16_t* MQK = (const bf16_t*)P.out; const bf16_t* MO = (const bf16_t*)((unsigned char*)P.out + UNIT);
    const bf16_t* MVT = (const bf16_t*)(ws + WS_MVT); bf16_t* Z = (bf16_t*)(ws + WS_Z);
    const bf16_t* CP = (const bf16_t*)(ws + WS_XN) + ((size_t)(bh * 32 + c) * 256) * 128;
    LAS bf16_t* QS = (LAS bf16_t*)lds; LAS bf16_t* KS = QS + 128 * KP; LAS bf16_t* SPm = KS + 128 * KP;
    LAS float* stage = (LAS float*)lds;
    LAS float* sm = (LAS float*)(lds + 133120);
    LAS float* s_a = sm; LAS float* s_pm = sm + 128; LAS float* s_bc = sm + 256; LAS float* s_n = sm + 384; LAS float* s_iw = sm + 512; LAS float* s_rd = sm + 640;
    const float mprev = ((const float*)(ws + MS_MPREV))[bh * 32 + c];
    bf16x8 cT[8], vT[8];
    { const bf16_t* cp = CP + (size_t)(32 * w + l32) * 128 + 8 * hi; const bf16_t* vp = MVT + (size_t)(h * 256 + 32 * w + l32) * T_TOK + tok0 + 8 * hi;
#pragma unroll
        for (int ks = 0; ks < 8; ++ks) { cT[ks] = *(const bf16x8*)(cp + 16 * ks); vT[ks] = *(const bf16x8*)(vp + 16 * ks); } }
    if (tid < 128) { const size_t o = (size_t)bh * SEQ + c * 128 + tid; s_a[tid] = ((const float*)(ws + MS_A))[o]; s_pm[tid] = ((const float*)(ws + MS_PM))[o]; s_bc[tid] = ((const float*)(ws + MS_BCUM))[o];
        s_n[tid] = ((const float*)(ws + MS_DN))[(size_t)(bh * 32 + c) * 128 + tid]; }
    for (int i = 0; i < 8; ++i) { const int task = i * NTHR + tid, g = task & 31, t = task >> 5; const bool isk = g >= 16; const int d8 = g & 15; float o[8];
        conv8(MQK, P.in[5], P.in[6], b, c * 128 + t, (isk ? 512 : 0) + h * 128 + d8 * 8, o);
        if (!isk) {
#pragma unroll
            for (int e = 0; e < 8; ++e) o[e] *= 0.08838834764831845f; }
        *(LAS u32x4*)((isk ? KS : QS) + t * KP + d8 * 8) = pack8(o); }
    __syncthreads();
    { const int tb = w & 3, sb0 = (w >> 2) * 2;
#pragma unroll
        for (int j = 0; j < 2; ++j) { const int sb = sb0 + j; f32x16 acc = (f32x16){};
            if (sb <= tb) {
#pragma unroll
                for (int ks = 0; ks < 8; ++ks) { const bf16x8 a = *(const LAS bf16x8*)(QS + (32 * tb + l32) * KP + 16 * ks + 8 * hi); const bf16x8 bb = *(const LAS bf16x8*)(KS + (32 * sb + l32) * KP + 16 * ks + 8 * hi); acc = MFMA32(a, bb, acc); } }
            const int s = 32 * sb + l32; const float as = s_a[s];
#pragma unroll
            for (int r = 0; r < 16; ++r) { const int t = 32 * tb + crow(r, hi); const float v = (s <= t) ? acc[r] * __expf(as - s_pm[t]) : 0.f; SPm[t * KP + s] = (bf16_t)f2bf(v); } } }
    __syncthreads();
    { const int t = tid >> 2, q = tid & 3; float s1 = 0.f, s2 = 0.f;
        for (int j = 0; j < 32; ++j) { s1 += bf2f(SPm[t * KP + 32 * q + j]); s2 += bf2f(QS[t * KP + 32 * q + j]) * s_n[32 * q + j]; }
        s1 += __shfl_xor(s1, 1); s1 += __shfl_xor(s1, 2); s2 += __shfl_xor(s2, 1); s2 += __shfl_xor(s2, 2);
        if (q == 0) { const float iw = __expf(mprev - s_pm[t]); const float den = s1 + iw * s2; const float lim = __expf(-(s_bc[t] + s_pm[t])); s_iw[t] = iw; s_rd[t] = 1.0f / fmaxf(fabsf(den), lim); } }
    __syncthreads();
    f32x16 acc[4];
#pragma unroll
    for (int tb = 0; tb < 4; ++tb) { acc[tb] = (f32x16){};
#pragma unroll
        for (int ks = 0; ks < 8; ++ks) { const bf16x8 a = *(const LAS bf16x8*)(QS + (32 * tb + l32) * KP + 16 * ks + 8 * hi); acc[tb] = MFMA32(a, cT[ks], acc[tb]); }
#pragma unroll
        for (int r = 0; r < 16; ++r) acc[tb][r] *= s_iw[32 * tb + crow(r, hi)];
#pragma unroll
        for (int ks = 0; ks < 8; ++ks) { if (ks < 2 * (tb + 1)) { const bf16x8 a = *(const LAS bf16x8*)(SPm + (32 * tb + l32) * KP + 16 * ks + 8 * hi); acc[tb] = MFMA32(a, vT[ks], acc[tb]); } }
#pragma unroll
        for (int r = 0; r < 16; ++r) acc[tb][r] *= s_rd[32 * tb + crow(r, hi)];
    }
    __syncthreads();
#pragma unroll
    for (int tb = 0; tb < 4; ++tb)
#pragma unroll
        for (int r = 0; r < 16; ++r) stage[(32 * tb + crow(r, hi)) * SP_F + 32 * w + l32] = acc[tb][r];
    __syncthreads();
    const float* hg = P.in[12];
    for (int i = 0; i < 8; ++i) { const int task = i * NTHR + tid, v8 = task & 31, t = task >> 5;
        const f32x4 h0 = *(const LAS f32x4*)(stage + t * SP_F + v8 * 8), h1 = *(const LAS f32x4*)(stage + t * SP_F + v8 * 8 + 4);
        float hv[8] = {h0.x, h0.y, h0.z, h0.w, h1.x, h1.y, h1.z, h1.w};
        const u32x4 ow = *(const u32x4*)(MO + (tok0 + t) * 1024 + h * 256 + v8 * 8); float of[8]; unpack8(ow, of);
        bf16_t* zp = Z + (tok0 + t) * 2048 + 1024 + h * 256 + v8 * 8; const u32x4 zw = *(const u32x4*)zp; float zf[8]; unpack8(zw, zf);
        float ss = 0.f;
#pragma unroll
        for (int e = 0; e < 8; ++e) { hv[e] *= sigmoid_f(of[e]); ss += hv[e] * hv[e]; }
        ss += __shfl_xor(ss, 1); ss += __shfl_xor(ss, 2); ss += __shfl_xor(ss, 4); ss += __shfl_xor(ss, 8); ss += __shfl_xor(ss, 16);
        const float rstd = 1.0f / sqrtf(ss * (1.f / 256.f) + EPS);
        const f32x4 g0 = *(const f32x4*)(hg + v8 * 8), g1 = *(const f32x4*)(hg + v8 * 8 + 4); const float gg[8] = {g0.x, g0.y, g0.z, g0.w, g1.x, g1.y, g1.z, g1.w};
        float y[8];
#pragma unroll
        for (int e = 0; e < 8; ++e) y[e] = hv[e] * rstd * gg[e] * silu_f(zf[e]);
        *(u32x4*)zp = pack8(y); }
    __syncthreads();
}

DI void da_combine(const Params& P, LAS unsigned char* lds, int vcu, int G) {
    const int tid = fresh_tid(), lane = tid & 63, wave = tid >> 6;
    LAS float* sl = (LAS float*)lds;
    if (wave == 0) { const float a = P.in[7][lane] * P.in[8][lane], bq = P.in[9][lane] * P.in[10][lane]; const float d1 = wave_sum(a), d2 = wave_sum(bq); if (lane == 0) sl[0] = expf(d1) - expf(d2) + 0.2f; }
    __syncthreads();
    const float lam = sl[0];
    unsigned char* ws = P.ws;
    const bf16_t* O1 = (const bf16_t*)P.out; const bf16_t* O2 = (const bf16_t*)((unsigned char*)P.out + UNIT); bf16_t* Z = (bf16_t*)(ws + WS_Z);
    float gg[16]; { const float* g = P.in[11] + (16 * lane & 127);
#pragma unroll
        for (int e = 0; e < 16; e += 4) { const f32x4 t = *(const f32x4*)(g + e); gg[e] = t.x * 0.8f; gg[e + 1] = t.y * 0.8f; gg[e + 2] = t.z * 0.8f; gg[e + 3] = t.w * 0.8f; } }
    const int gw = vcu * 8 + wave, NGW = G * 8;
    for (int m = gw; m < T_TOK; m += NGW) {
        const size_t o = (size_t)m * 1024 + 16 * lane; bf16_t* zp = Z + (size_t)m * 2048 + 16 * lane;
        float a[16], bq[16], z[16];
        { float t[8]; unpack8(*(const u32x4*)(O1 + o), t); for (int e = 0; e < 8; ++e) a[e] = t[e]; unpack8(*(const u32x4*)(O1 + o + 8), t); for (int e = 0; e < 8; ++e) a[8 + e] = t[e];
          unpack8(*(const u32x4*)(O2 + o), t); for (int e = 0; e < 8; ++e) bq[e] = t[e]; unpack8(*(const u32x4*)(O2 + o + 8), t); for (int e = 0; e < 8; ++e) bq[8 + e] = t[e];
          unpack8(*(const u32x4*)zp, t); for (int e = 0; e < 8; ++e) z[e] = t[e]; unpack8(*(const u32x4*)(zp + 8), t); for (int e = 0; e < 8; ++e) z[8 + e] = t[e]; }
        float ss = 0.f;
#pragma unroll
        for (int e = 0; e < 16; ++e) { a[e] -= lam * bq[e]; ss += a[e] * a[e]; }
        ss += __shfl_xor(ss, 1); ss += __shfl_xor(ss, 2); ss += __shfl_xor(ss, 4);
        const float rstd = 1.0f / sqrtf(ss * (1.f / 128.f) + EPS);
        float y0[8], y1[8];
#pragma unroll
        for (int e = 0; e < 8; ++e) { y0[e] = a[e] * rstd * gg[e] * silu_f(z[e]); y1[e] = a[8 + e] * rstd * gg[8 + e] * silu_f(z[8 + e]); }
        *(u32x4*)zp = pack8(y0); *(u32x4*)(zp + 8) = pack8(y1);
    }
}

template <bool XNOUT> DI void resid_rows(const float* base, const bf16_t* Y, const float* rsq, const float* post_g, const float* pre_g, float* outf, bf16_t* XN, int vcu, int G) {
    const int tid = fresh_tid(), lane = tid & 63, wave = tid >> 6;
    float pg[16], ng[16];
#pragma unroll
    for (int hf = 0; hf < 2; ++hf)
#pragma unroll
        for (int q = 0; q < 2; ++q) { const int col = hf * 512 + 8 * lane + 4 * q; const f32x4 t = *(const f32x4*)(post_g + col); pg[hf * 8 + q * 4] = t.x; pg[hf * 8 + q * 4 + 1] = t.y; pg[hf * 8 + q * 4 + 2] = t.z; pg[hf * 8 + q * 4 + 3] = t.w;
            if (XNOUT) { const f32x4 u = *(const f32x4*)(pre_g + col); ng[hf * 8 + q * 4] = u.x; ng[hf * 8 + q * 4 + 1] = u.y; ng[hf * 8 + q * 4 + 2] = u.z; ng[hf * 8 + q * 4 + 3] = u.w; } }
    const int gw = vcu * 8 + wave, NGW = G * 8;
    for (int m = gw; m < T_TOK; m += NGW) {
        float sq = rsq[(size_t)(lane & 15) * T_TOK + m]; sq += __shfl_xor(sq, 1); sq += __shfl_xor(sq, 2); sq += __shfl_xor(sq, 4); sq += __shfl_xor(sq, 8);
        const float rstd = 1.0f / sqrtf(sq * (1.f / 1024.f) + EPS);
        float hv[16]; float ss = 0.f;
#pragma unroll
        for (int hf = 0; hf < 2; ++hf) { const size_t o = (size_t)m * 1024 + hf * 512 + 8 * lane; float yf[8]; unpack8(*(const u32x4*)(Y + o), yf);
            const f32x4 b0 = *(const f32x4*)(base + o), b1 = *(const f32x4*)(base + o + 4); const float bb[8] = {b0.x, b0.y, b0.z, b0.w, b1.x, b1.y, b1.z, b1.w};
#pragma unroll
            for (int e = 0; e < 8; ++e) { const float v = bb[e] + yf[e] * rstd * pg[hf * 8 + e]; hv[hf * 8 + e] = v; ss += v * v; }
            *(f32x4*)(outf + o) = (f32x4){hv[hf * 8], hv[hf * 8 + 1], hv[hf * 8 + 2], hv[hf * 8 + 3]}; *(f32x4*)(outf + o + 4) = (f32x4){hv[hf * 8 + 4], hv[hf * 8 + 5], hv[hf * 8 + 6], hv[hf * 8 + 7]}; }
        if (XNOUT) { const float r2 = 1.0f / sqrtf(wave_sum(ss) * (1.f / 1024.f) + EPS);
#pragma unroll
            for (int hf = 0; hf < 2; ++hf) { float xo[8];
#pragma unroll
                for (int e = 0; e < 8; ++e) xo[e] = hv[hf * 8 + e] * r2 * ng[hf * 8 + e];
                *(u32x4*)(XN + (size_t)m * 1024 + hf * 512 + 8 * lane) = pack8(xo); } }
    }
}

DI void spatial_unit(const Params& P, LAS unsigned char* lds, int bc, int g) {
    const int tid = fresh_tid(), lane = tid & 63, w = tid >> 6, l32 = lane & 31, hi = lane >> 5;
    const size_t tok0 = (size_t)bc * 128;
    unsigned char* ws = P.ws;
    const bf16_t* VT = (const bf16_t*)(ws + WS_VT1); bf16_t* U = (bf16_t*)(ws + WS_U); const bf16_t* SZ = (const bf16_t*)(ws + WS_SZ);
    const float* csq = (const float*)(ws + MS_CSQ);
    LAS bf16_t* AW = (LAS bf16_t*)lds; LAS float* stage = (LAS float*)lds; LAS float* rs = (LAS float*)(lds + 133120);
    bf16x8 bv[8]; { const bf16_t* vp = VT + (size_t)(g * 256 + 32 * w + l32) * T_TOK + tok0 + 8 * hi;
#pragma unroll
        for (int ks = 0; ks < 8; ++ks) bv[ks] = *(const bf16x8*)(vp + 16 * ks); }
    if (tid < 128) { float s = 0.f; for (int p = 0; p < 16; ++p) s += csq[(size_t)p * T_TOK + tok0 + tid]; rs[tid] = 1.0f / sqrtf(s * (1.f / 2048.f) + EPS); }
    __syncthreads();
    const float* wsp = P.in[18] + (size_t)g * 128 * 128;
    for (int i = 0; i < 8; ++i) { const int task = i * NTHR + tid, s4 = task & 31, t = task >> 5; const f32x4 wv = *(const f32x4*)(wsp + t * 128 + s4 * 4); float o[4];
#pragma unroll
        for (int e = 0; e < 4; ++e) { const int s = s4 * 4 + e; o[e] = (s <= t) ? wv[e] * rs[s] : 0.f; }
        u32x2 pk; pk.x = pk2(o[0], o[1]); pk.y = pk2(o[2], o[3]); *(LAS u32x2*)(AW + t * KP + s4 * 4) = pk; }
    __syncthreads();
    f32x16 acc[4];
    const float gn = P.in[17][g * 256 + 32 * w + l32];
#pragma unroll
    for (int tb = 0; tb < 4; ++tb) { acc[tb] = (f32x16){};
#pragma unroll
        for (int ks = 0; ks < 8; ++ks) { if (ks < 2 * (tb + 1)) { const bf16x8 a = *(const LAS bf16x8*)(AW + (32 * tb + l32) * KP + 16 * ks + 8 * hi); acc[tb] = MFMA32(a, bv[ks], acc[tb]); } } }
    __syncthreads();
    const float* bsp = P.in[19] + g * 128;
#pragma unroll
    for (int tb = 0; tb < 4; ++tb)
#pragma unroll
        for (int r = 0; r < 16; ++r) { const int t = 32 * tb + crow(r, hi); stage[t * SP_F + 32 * w + l32] = acc[tb][r] * gn + bsp[t]; }
    __syncthreads();
    for (int i = 0; i < 8; ++i) { const int task = i * NTHR + tid, d8 = task & 31, t = task >> 5;
        const f32x4 h0 = *(const LAS f32x4*)(stage + t * SP_F + d8 * 8), h1 = *(const LAS f32x4*)(stage + t * SP_F + d8 * 8 + 4); const float vs[8] = {h0.x, h0.y, h0.z, h0.w, h1.x, h1.y, h1.z, h1.w};
        const size_t o = (tok0 + t) * 2048 + g * 256 + d8 * 8; float uf[8], zf[8]; unpack8(*(const u32x4*)(U + o), uf); unpack8(*(const u32x4*)(SZ + o), zf); float y[8];
#pragma unroll
        for (int e = 0; e < 8; ++e) y[e] = pg8::act_gelu_tanh(uf[e]) * vs[e] * silu_f(zf[e]);
        *(u32x4*)(U + o) = pack8(y); }
    __syncthreads();
}

#ifndef PHM
#define PHM 0xFFFF
#endif
typedef const __attribute__((address_space(4))) Params* KParamsPtr;
DI KParamsPtr launder_kp(KParamsPtr p) { asm volatile("" : "+s"(p)); return p; }
DI Params load_params(KParamsPtr p) { Params r;
#pragma unroll
    for (int i = 0; i < 22; ++i) r.in[i] = p->in[i];
    r.out = p->out; r.ws = p->ws; return r; }
#define LOADP() const Params P = load_params(launder_kp(kp_)); unsigned char* const ws = P.ws; unsigned char* const ob = (unsigned char*)P.out; (void)ws; (void)ob
__global__ void __launch_bounds__(NTHR, 2) mega_fwd(Params Pk_unused) {
    KParamsPtr kp_ = (KParamsPtr)__builtin_amdgcn_kernarg_segment_ptr();
    extern __shared__ __attribute__((aligned(16))) unsigned char lds_raw[];
    LAS unsigned char* lds = (LAS unsigned char*)lds_raw;
    cg::grid_group grid = cg::this_grid();
    const int G = gridDim.x, bx = blockIdx.x;
    const int vcu = (G % 8 == 0) ? (bx % 8) * (G / 8) + bx / 8 : bx;
    typedef pg8::bf16_t pbf;
    volatile LAS unsigned* xst = (volatile LAS unsigned*)(lds + LDS_BYTES - 16);
    if (fresh_tid() == 0) { xst[0] = 0u; xst[1] = 0u; }
    __syncthreads();

    if constexpr ((PHM >> 0) & 1) { LOADP();
    if (bx == 0) { unsigned* bw = (unsigned*)(ws + MS_BAR); for (int i = fresh_tid(); i < XCD_BAR_WORDS; i += NTHR) bw[i] = 0u; }
    p0_prologue(P, lds, vcu, G);
    }
    grid.sync();
    XcdBarrier xbar; { const Params Pb = load_params(launder_kp(kp_)); xbar = xcd_barrier_post((unsigned*)(Pb.ws + MS_BAR), xst); }

    if constexpr ((PHM >> 1) & 1) { LOADP();
    for (int bh = bx; bh < 32; bh += G) gate_scan(P, lds, bh);
    { pg8::Gemm g{(const pbf*)(ws + WS_XN), (const pbf*)(ws + MS_WT1), T_TOK, 7168, 1024, 1024, 1024}; pg8::StaticOrder S; S.init(T_TOK, 7168, G, bx);
      pg8::Epi1 E{ws, ob, attn_body::C2};
      pg8::gemm_phase<pg8::Epi1, pg8::StaticOrder, true, true>(lds, g, S, E); }
    { pg8::Gemm g{(const pbf*)(ws + MS_WT1) + (size_t)7168 * 1024, (const pbf*)(ws + WS_XN), 1024, T_TOK, 1024, 1024, 1024}; pg8::StaticOrder S; S.init(1024, T_TOK, G, bx);
      pg8::EpiT<0, false> E{(pbf*)(ws + WS_MVT), T_TOK, nullptr, T_TOK};
      pg8::gemm_phase<pg8::EpiT<0, false>, pg8::StaticOrder, true, true>(lds, g, S, E); }
    }
    xcd_barrier(xbar);
    if constexpr ((PHM >> 2) & 1) { LOADP();
    for (int u = vcu; u < 1024; u += G) mlstm_i_unit(P, lds, u >> 5, u & 31);
    }
    xcd_barrier(xbar);
    if constexpr ((PHM >> 3) & 1) { LOADP();
    mlstm_scan(P, vcu, G);
    }
    xcd_barrier(xbar);
    if constexpr ((PHM >> 4) & 1) { LOADP();
    for (int u = vcu; u < 1024; u += G) mlstm_out_unit(P, lds, u >> 5, u & 31);
    }
    xcd_barrier(xbar);
    if constexpr ((PHM >> 5) & 1) { LOADP();
    { const attn_body::AttnTensors AT{(const attn_body::bf16*)(ws + WS_Q), (const attn_body::bf16*)(ws + WS_K), (const attn_body::bf16*)(ws + WS_V), (attn_body::bf16*)(ob), (attn_body::bf16*)(ob + UNIT)};
      const attn_body::StaticOrder S(vcu, G); attn_body::attn_phase<attn_body::StaticOrder>((char*)lds_raw, AT, S); }
    }
    xcd_barrier(xbar);
    if constexpr ((PHM >> 6) & 1) { LOADP();
    da_combine(P, lds, vcu, G);
    }
    xcd_barrier(xbar);
    if constexpr ((PHM >> 7) & 1) { LOADP();
    { pg8::Gemm g{(const pbf*)(ws + WS_Z), (const pbf*)(ws + MS_WO0), T_TOK, 1024, 2048, 2048, 2048}; pg8::StaticOrder S; S.init(T_TOK, 1024, G, bx);
      pg8::EpiY E{(pbf*)(ws + WS_Y0), (float*)(ws + MS_RSQ), T_TOK};
      pg8::gemm_phase<pg8::EpiY, pg8::StaticOrder, true, true>(lds, g, S, E); }
    }
    xcd_barrier(xbar);
    if constexpr ((PHM >> 8) & 1) { LOADP();
    resid_rows<true>(P.in[0], (const bf16_t*)(ws + WS_Y0), (const float*)(ws + MS_RSQ), P.in[14], P.in[15], P.out, (bf16_t*)(ws + WS_XN), vcu, G);
    }
    xcd_barrier(xbar);
    if constexpr ((PHM >> 9) & 1) { LOADP();
    { pg8::Gemm g{(const pbf*)(ws + WS_XN), (const pbf*)(ws + MS_WUZ), T_TOK, 4096, 1024, 1024, 1024}; pg8::StaticOrder S; S.init(T_TOK, 4096, G, bx);
      pg8::EpiUZ E{(pbf*)(ws + WS_U), (pbf*)(ws + WS_SZ)};
      pg8::gemm_phase<pg8::EpiUZ, pg8::StaticOrder, true, true>(lds, g, S, E); }
    { pg8::Gemm g{(const pbf*)(ws + MS_WV), (const pbf*)(ws + WS_XN), 2048, T_TOK, 1024, 1024, 1024}; pg8::StaticOrder S; S.init(2048, T_TOK, G, bx);
      pg8::EpiT<1, true> E{(pbf*)(ws + WS_VT1), T_TOK, (float*)(ws + MS_CSQ), T_TOK};
      pg8::gemm_phase<pg8::EpiT<1, true>, pg8::StaticOrder, true, true>(lds, g, S, E); }
    }
    xcd_barrier(xbar);
    if constexpr ((PHM >> 10) & 1) { LOADP();
    for (int u = vcu; u < 2048; u += G) spatial_unit(P, lds, u >> 3, u & 7);
    }
    xcd_barrier(xbar);
    if constexpr ((PHM >> 11) & 1) { LOADP();
    { pg8::Gemm g{(const pbf*)(ws + WS_U), (const pbf*)(ws + MS_WO1), T_TOK, 1024, 2048, 2048, 2048}; pg8::StaticOrder S; S.init(T_TOK, 1024, G, bx);
      pg8::EpiY E{(pbf*)(ws + WS_Y1), (float*)(ws + MS_RSQ), T_TOK};
      pg8::gemm_phase<pg8::EpiY, pg8::StaticOrder, true, true>(lds, g, S, E); }
    }
    xcd_barrier(xbar);
    if constexpr ((PHM >> 12) & 1) { LOADP();
    resid_rows<false>(P.out, (const bf16_t*)(ws + WS_Y1), (const float*)(ws + MS_RSQ), P.in[21], nullptr, P.out, nullptr, vcu, G);
    }
}

extern "C" void kernel_launch(void* const* d_in, const int* in_sizes, int n_in, void* d_out, int out_size, void* d_ws, size_t ws_size, hipStream_t stream) {
    static int grid = 0;
    if (grid == 0) {
        if (n_in != 22 || ws_size < WS_NEED || out_size != T_TOK * DM) { fprintf(stderr, "kernel_launch: unexpected shapes (n_in %d, out %d, ws %zu)\n", n_in, out_size, ws_size); grid = -1; return; }
        int dev = 0, cus = 0, per_cu = 0;
        hipGetDevice(&dev); hipDeviceGetAttribute(&cus, hipDeviceAttributeMultiprocessorCount, dev);
        hipFuncSetAttribute((const void*)mega_fwd, hipFuncAttributeMaxDynamicSharedMemorySize, LDS_BYTES);
        if (hipOccupancyMaxActiveBlocksPerMultiprocessor(&per_cu, (const void*)mega_fwd, NTHR, LDS_BYTES) != hipSuccess || per_cu < 1) per_cu = 1;
        (void)hipGetLastError();
        grid = cus * 1;
        if (grid <= 0) grid = 256;
    }
    if (grid < 0) return;
    Params p{};
    for (int i = 0; i < 22; ++i) p.in[i] = (const float*)d_in[i];
    p.out = (float*)d_out; p.ws = (unsigned char*)d_ws;
    void* args[] = {&p};
    hipError_t e = hipLaunchCooperativeKernel((const void*)mega_fwd, dim3(grid), dim3(NTHR), args, LDS_BYTES, stream);
    if (e != hipSuccess) fprintf(stderr, "cooperative launch failed: %s (grid %d)\n", hipGetErrorString(e), grid);
}
```
